# Optimizing an MI355X kernel written in HIP

```python
import math
import jax
import jax.numpy as jnp
from jax import lax
import numpy as np

D_MODEL = 2048
BATCH = 4
SEQ = 2048
DEPTH = 2

M_HEADS = 4
M_DH = 256
M_W = M_HEADS * M_DH
CONV_K = 4
A_HEADS = 8
A_DH = 64
A_W = A_HEADS * 2 * A_DH
ROT_DIM = A_DH // 4
ROPE_THETA = 500000.0
Q_BLOCK = 128
G_HEADS = 8
G_DK = 128
G_DV = 128
G_WK = G_HEADS * G_DK
G_WV = G_HEADS * G_DV
CHUNK = 64
N_BRANCH = 3
D_FF = 4 * D_MODEL
ALPHA = (2 * DEPTH) ** 0.25
BETA = (8 * DEPTH) ** -0.25
LN_EPS = 1e-5
NORM_EPS = 1e-6
NEG_BIG = -1e30
F_FLOOR = 1e-30

IN_SIZES = (M_W, M_W, M_W, M_W, M_HEADS, M_HEADS,
            A_W, A_W, A_W,
            G_WK, G_WK, G_WV, G_WV,
            N_BRANCH * D_MODEL)
IN_WIDTH = sum(IN_SIZES)

kernel_name = 'hybrid_mlstm_diffattn_hgrn2_deepnorm'


def layer_norm(x, w, b):
    xf = x.astype(jnp.float32)
    mu = jnp.mean(xf, -1, keepdims=True)
    var = jnp.mean(jnp.square(xf - mu), -1, keepdims=True)
    return ((xf - mu) * lax.rsqrt(var + LN_EPS)).astype(x.dtype) * w + b


def head_rms_norm(x, w):
    xf = x.astype(jnp.float32)
    H, d = x.shape[-2:]
    y = xf * lax.rsqrt(jnp.mean(jnp.square(xf), -1, keepdims=True) + NORM_EPS)
    return y * w.astype(jnp.float32).reshape(H, d)


def causal_dwconv(x, w, b):
    C = x.shape[-1]
    y = lax.conv_general_dilated(x, w[:, None, :].astype(x.dtype), window_strides=(1,),
                                 padding=[(CONV_K - 1, 0)],
                                 dimension_numbers=('NWC', 'WIO', 'NWC'),
                                 feature_group_count=C)
    return y + b


def rope_cos_sin(positions):
    inv = jnp.power(jnp.float32(ROPE_THETA), -jnp.arange(0, ROT_DIM, 2, dtype=jnp.float32) / ROT_DIM)
    ang = positions.astype(jnp.float32)[..., None] * inv
    return jnp.cos(ang), jnp.sin(ang)


def partial_rope(x, cos, sin):
    half = ROT_DIM // 2
    c = cos[:, :, None, None, :].astype(x.dtype)
    s = sin[:, :, None, None, :].astype(x.dtype)
    x1, x2, rest = x[..., :half], x[..., half:ROT_DIM], x[..., ROT_DIM:]
    return jnp.concatenate([x1 * c - x2 * s, x2 * c + x1 * s, rest], axis=-1)


def to_chunks(t):
    B, S, H = t.shape[:3]
    t = t.reshape((B, S // CHUNK, CHUNK, H) + t.shape[3:])
    return jnp.moveaxis(t, (1, 3), (0, 2))


def from_chunks(t):
    n, B, H, C = t.shape[:4]
    t = jnp.moveaxis(t, (0, 2), (1, 3))
    return t.reshape((B, n * C, H) + t.shape[4:])


def mlstm_chunkwise(q, k, v, i_pre, f_pre):
    B, S, H, d = q.shape
    f32 = jnp.float32
    q = q.astype(f32)
    k = k.astype(f32) * (d ** -0.5)
    v = v.astype(f32)
    log_f = jax.nn.log_sigmoid(f_pre.astype(f32))
    log_i = i_pre.astype(f32)
    causal = jnp.tril(jnp.ones((CHUNK, CHUNK), dtype=bool))

    def step(carry, inp):
        C_prev, n_prev, m_prev = carry
        qc, kc, vc, ic, lfc = inp
        b = jnp.cumsum(lfc, axis=-1)
        log_d = b[..., :, None] - b[..., None, :] + ic[..., None, :]
        log_d = jnp.where(causal, log_d, NEG_BIG)
        log_inter = b + m_prev[..., None]
        m_t = jnp.maximum(log_inter, jnp.max(log_d, -1))
        w_inter = jnp.exp(log_inter - m_t)
        s = jnp.einsum('bhtd,bhsd->bhts', qc, kc) * jnp.exp(log_d - m_t[..., None])
        num = (jnp.einsum('bhts,bhse->bhte', s, vc)
               + w_inter[..., None] * jnp.einsum('bhtd,bhde->bhte', qc, C_prev))
        den = jnp.sum(s, -1) + w_inter * jnp.einsum('bhtd,bhd->bht', qc, n_prev)
        h = num / jnp.maximum(jnp.abs(den), jnp.exp(-m_t))[..., None]
        g = b[..., -1]
        log_w = g[..., None] - b + ic
        m_new = jnp.maximum(g + m_prev, jnp.max(log_w, -1))
        w_s = jnp.exp(log_w - m_new[..., None])
        decay = jnp.exp(g + m_prev - m_new)
        C_new = decay[..., None, None] * C_prev + jnp.einsum('bhs,bhsd,bhse->bhde', w_s, kc, vc)
        n_new = decay[..., None] * n_prev + jnp.einsum('bhs,bhsd->bhd', w_s, kc)
        return (C_new, n_new, m_new), h

    init = (jnp.zeros((B, H, d, d), f32), jnp.zeros((B, H, d), f32), jnp.zeros((B, H), f32))
    _, h = lax.scan(step, init, (to_chunks(q), to_chunks(k), to_chunks(v),
                                 to_chunks(log_i), to_chunks(log_f)))
    return from_chunks(h)


def hgrn2_chunkwise(q, k, v, log_f):
    B, S, H, dk = q.shape
    dv = v.shape[-1]
    f32 = jnp.float32
    q, k, v, log_f = (t.astype(f32) for t in (q, k, v, log_f))
    causal = jnp.tril(jnp.ones((CHUNK, CHUNK), dtype=bool))[:, :, None]

    def step(S_prev, inp):
        qc, kc, vc, lfc = inp
        b = jnp.cumsum(lfc, axis=2)
        rel = b[:, :, :, None, :] - b[:, :, None, :, :]
        rel = jnp.where(causal, rel, NEG_BIG)
        attn = jnp.einsum('bhtk,bhsk,bhtsk->bhts', qc, kc, jnp.exp(rel))
        o = (jnp.einsum('bhts,bhsv->bhtv', attn, vc)
             + jnp.einsum('bhtk,bhkv->bhtv', qc * jnp.exp(b), S_prev))
        b_last = b[:, :, -1]
        S_new = (jnp.exp(b_last)[..., None] * S_prev
                 + jnp.einsum('bhsk,bhsv->bhkv', kc * jnp.exp(b_last[:, :, None] - b), vc))
        return S_new, o

    _, o = lax.scan(step, jnp.zeros((B, H, dk, dv), f32),
                    (to_chunks(q), to_chunks(k), to_chunks(v), to_chunks(log_f)))
    return from_chunks(o)


def diff_attention(q, k, v, lam):
    B, S, H, _, d = q.shape
    nb = S // Q_BLOCK
    scale = d ** -0.5
    kpos = jnp.arange(S)
    qb = jnp.moveaxis(q.reshape(B, nb, Q_BLOCK, H, 2, d), 1, 0)

    def block(args):
        qblk, start = args
        s = jnp.einsum('bqhnd,bkhnd->bhnqk', qblk, k).astype(jnp.float32) * scale
        qpos = start + jnp.arange(Q_BLOCK)
        s = jnp.where(kpos[None, :] <= qpos[:, None], s, NEG_BIG)
        p = jax.nn.softmax(s, axis=-1)
        a = p[:, :, 0] - lam * p[:, :, 1]
        return jnp.einsum('bhqk,bkhe->bqhe', a.astype(v.dtype), v)

    out = lax.map(block, (qb, jnp.arange(nb) * Q_BLOCK))
    return jnp.moveaxis(out, 0, 1).reshape(B, S, H, 2 * d)


def mixer_sublayer(u, layer_idx, cos, sin, lb, w_in, conv_w, conv_b, gate_b, m_norm_w,
                   lam_vecs, a_norm_w, g_norm_w, p_m, p_a, p_g, w_out):
    B, S, _ = u.shape
    f32 = jnp.float32
    split_at = np.cumsum(IN_SIZES)[:-1].tolist()
    (mq, mk, mv, mo, mi, mf, aq, ak, av, gq, gf, gi, gg, gate_pre) = jnp.split(u @ w_in, split_at, axis=-1)

    qk = jax.nn.silu(causal_dwconv(jnp.concatenate([mq, mk], axis=-1), conv_w, conv_b))
    mq, mk = jnp.split(qk, 2, axis=-1)
    hshape = (B, S, M_HEADS, M_DH)
    hm = mlstm_chunkwise(mq.reshape(hshape), mk.reshape(hshape), mv.reshape(hshape),
                         mi + gate_b[:M_HEADS], mf + gate_b[M_HEADS:])
    hm = head_rms_norm(hm, m_norm_w) * jax.nn.sigmoid(mo.astype(f32)).reshape(hshape)
    hm = hm.astype(u.dtype).reshape(B, S, M_W)

    aq = partial_rope(aq.reshape(B, S, A_HEADS, 2, A_DH), cos, sin)
    ak = partial_rope(ak.reshape(B, S, A_HEADS, 2, A_DH), cos, sin)
    lam_init = 0.8 - 0.6 * math.exp(-0.3 * layer_idx)
    lv = lam_vecs.astype(f32)
    lam = jnp.exp(jnp.sum(lv[0] * lv[1])) - jnp.exp(jnp.sum(lv[2] * lv[3])) + lam_init
    ha = diff_attention(aq, ak, av.reshape(B, S, A_HEADS, 2 * A_DH), lam)
    ha = (head_rms_norm(ha, a_norm_w) * (1.0 - lam_init)).astype(u.dtype).reshape(B, S, A_W)

    f_g = lb + (1.0 - lb) * jax.nn.sigmoid(gf.astype(f32))
    log_f = jnp.log(jnp.maximum(f_g, F_FLOOR))
    k_g = 1.0 - f_g
    kshape = (B, S, G_HEADS, G_DK)
    hg = hgrn2_chunkwise(jax.nn.silu(gq).reshape(kshape), k_g.reshape(kshape),
                         gi.reshape(B, S, G_HEADS, G_DV), log_f.reshape(kshape))
    hg = head_rms_norm(hg, g_norm_w) * jax.nn.silu(gg.astype(f32)).reshape(B, S, G_HEADS, G_DV)
    hg = hg.astype(u.dtype).reshape(B, S, G_WV)

    gates = jax.nn.sigmoid(gate_pre).reshape(B, S, N_BRANCH, D_MODEL)
    y = (gates[:, :, 0] * (hm @ p_m) + gates[:, :, 1] * (ha @ p_a) + gates[:, :, 2] * (hg @ p_g))
    return y @ w_out


def squared_relu_mlp(u, w_up, w_down):
    return jnp.square(jax.nn.relu(u @ w_up)) @ w_down


def setup_inputs(seed: int = 0) -> dict:
    key = jax.random.key(seed)
    ks = iter(jax.random.split(key, 32))
    L = DEPTH

    def nrm(shape, scale):
        return scale * jax.random.normal(next(ks), shape, jnp.float32)

    x = nrm((BATCH, SEQ, D_MODEL), 1.0)
    positions = jnp.broadcast_to(jnp.arange(SEQ, dtype=jnp.int32), (BATCH, SEQ))
    ln0_w = 1.0 + nrm((D_MODEL,), 0.02)
    ln0_b = nrm((D_MODEL,), 0.02)
    w_in = nrm((L, D_MODEL, IN_WIDTH), D_MODEL ** -0.5)
    m_conv_w = nrm((L, CONV_K, 2 * M_W), CONV_K ** -0.5)
    m_conv_b = nrm((L, 2 * M_W), 0.02)
    f_bias = jnp.linspace(3.0, 6.0, M_HEADS, dtype=jnp.float32)
    m_gate_b = jnp.concatenate([nrm((L, M_HEADS), 0.1), f_bias + nrm((L, M_HEADS), 0.1)], axis=-1)
    m_norm_w = 1.0 + nrm((L, M_W), 0.02)
    a_lambda = nrm((L, 4, A_DH), 0.1)
    a_norm_w = 1.0 + nrm((L, A_W), 0.02)
    g_lb_logits = nrm((L, G_WK), 0.5)
    g_norm_w = 1.0 + nrm((L, G_WV), 0.02)
    p_m = nrm((L, M_W, D_MODEL), M_W ** -0.5)
    p_a = nrm((L, A_W, D_MODEL), A_W ** -0.5)
    p_g = nrm((L, G_WV, D_MODEL), G_WV ** -0.5)
    w_out = nrm((L, D_MODEL, D_MODEL), BETA * D_MODEL ** -0.5)
    ln1_w = 1.0 + nrm((L, D_MODEL), 0.02)
    ln1_b = nrm((L, D_MODEL), 0.02)
    w_up = nrm((L, D_MODEL, D_FF), D_MODEL ** -0.5)
    w_down = nrm((L, D_FF, D_MODEL), BETA * D_FF ** -0.5)
    ln2_w = 1.0 + nrm((L, D_MODEL), 0.02)
    ln2_b = nrm((L, D_MODEL), 0.02)
    return {'x': x, 'positions': positions, 'ln0_w': ln0_w, 'ln0_b': ln0_b, 'w_in': w_in,
            'm_conv_w': m_conv_w, 'm_conv_b': m_conv_b, 'm_gate_b': m_gate_b, 'm_norm_w': m_norm_w,
            'a_lambda': a_lambda, 'a_norm_w': a_norm_w, 'g_lb_logits': g_lb_logits,
            'g_norm_w': g_norm_w, 'p_m': p_m, 'p_a': p_a, 'p_g': p_g, 'w_out': w_out,
            'ln1_w': ln1_w, 'ln1_b': ln1_b, 'w_up': w_up, 'w_down': w_down,
            'ln2_w': ln2_w, 'ln2_b': ln2_b}


def reference(x, positions, ln0_w, ln0_b, w_in, m_conv_w, m_conv_b, m_gate_b, m_norm_w,
              a_lambda, a_norm_w, g_lb_logits, g_norm_w, p_m, p_a, p_g, w_out,
              ln1_w, ln1_b, w_up, w_down, ln2_w, ln2_b):
    cos, sin = rope_cos_sin(positions)
    p_lb = jax.nn.softmax(g_lb_logits.astype(jnp.float32), axis=0)
    lower_bounds = jnp.cumsum(p_lb, axis=0) - p_lb[0]
    h = layer_norm(x, ln0_w, ln0_b)
    for l in range(DEPTH):
        mix = mixer_sublayer(h, l, cos, sin, lower_bounds[l], w_in[l], m_conv_w[l], m_conv_b[l],
                             m_gate_b[l], m_norm_w[l], a_lambda[l], a_norm_w[l], g_norm_w[l],
                             p_m[l], p_a[l], p_g[l], w_out[l])
        h = layer_norm(ALPHA * h + mix, ln1_w[l], ln1_b[l])
        ff = squared_relu_mlp(h, w_up[l], w_down[l])
        h = layer_norm(ALPHA * h + ff, ln2_w[l], ln2_b[l])
    return h
```

```cpp
#include <hip/hip_runtime.h>
#include <hip/hip_cooperative_groups.h>
#include <cstdio>
#include <cstdint>
namespace cg = cooperative_groups;

#define LAS __attribute__((address_space(3)))
typedef unsigned short bf16_t;
typedef short bf16x8 __attribute__((ext_vector_type(8)));
typedef float f32x4 __attribute__((ext_vector_type(4)));
typedef unsigned u32x4 __attribute__((ext_vector_type(4)));
typedef unsigned u32x2 __attribute__((ext_vector_type(2)));

constexpr int T = 8192, SEQ = 2048, D = 2048, NP = 17408, NSRC = 17416, FF = 8192, DEPTH = 2;
constexpr int C_MQ = 0, C_MK = 1024, C_MV = 2048, C_MO = 3072, C_AQ = 4096, C_AK = 5120, C_AV = 6144, C_GQ = 7168, C_GF = 8192, C_GI = 9216, C_GG = 10240, C_GATE = 11264;
constexpr float ALPHA = 1.41421356237f;
constexpr float LN_EPS = 1e-5f, NORM_EPS = 1e-6f;
constexpr int NTHREADS = 512, NWAVES = 8;
constexpr int LDS_BYTES = 159744;
#ifndef REP_P0
#define REP_P0 1
#endif
#ifndef REP_GEMM
#define REP_GEMM 1
#endif
#ifndef REP_M
#define REP_M 1
#endif
#ifndef REP_H
#define REP_H 1
#endif
#ifndef REP_A
#define REP_A 1
#endif

constexpr size_t SZ_WIN = (size_t)NP * D * 2, SZ_WP = (size_t)2048 * 1024 * 2, SZ_WOUT = (size_t)D * D * 2, SZ_WUP = (size_t)FF * D * 2, SZ_WDN = (size_t)D * FF * 2;
constexpr size_t WS_WIN = 0;
constexpr size_t WS_WPM = WS_WIN + DEPTH * SZ_WIN;
constexpr size_t WS_WPA = WS_WPM + DEPTH * SZ_WP;
constexpr size_t WS_WPG = WS_WPA + DEPTH * SZ_WP;
constexpr size_t WS_WOUT = WS_WPG + DEPTH * SZ_WP;
constexpr size_t WS_WUP = WS_WOUT + DEPTH * SZ_WOUT;
constexpr size_t WS_WDN = WS_WUP + DEPTH * SZ_WUP;
constexpr size_t WS_H = WS_WDN + DEPTH * SZ_WDN;
constexpr size_t WS_HB = WS_H + (size_t)T * D * 4;
constexpr size_t WS_PROJ = WS_HB + (size_t)T * D * 2;
constexpr size_t WS_HCAT = WS_PROJ + (size_t)T * NP * 2;
constexpr size_t WS_HPART = WS_HCAT + (size_t)3 * T * 1024 * 2;
constexpr size_t WS_YF = WS_HPART + (size_t)2 * T * 1024 * 4;
constexpr size_t WS_YB = WS_YF + (size_t)T * D * 4;
constexpr size_t WS_TF = WS_YB + (size_t)T * D * 2;
constexpr size_t WS_MPART = WS_YF;
constexpr size_t WS_GIF = WS_TF + (size_t)T * D * 4;
constexpr size_t WS_ROPE = WS_GIF + (size_t)T * 8 * 4;
constexpr size_t WS_DPART = WS_ROPE + (size_t)T * 16 * 4;
constexpr size_t WS_BAR = WS_DPART + (size_t)4 * T * 4 * 4;
static_assert((size_t)4 * T * 1024 * 4 <= (size_t)T * D * 4 + (size_t)T * D * 2 + (size_t)T * D * 4, "MPART fits in YF | YB | TF");
constexpr size_t WS_CNT = WS_BAR + 16384;
constexpr size_t WS_ZERO_BYTES = 16384 + 4 * 32 * 256;
constexpr size_t WS_XBUF = WS_CNT + 4 * 32 * 256;
constexpr size_t WS_GPART = WS_XBUF + (size_t)4 * T * 8 * 8;
constexpr size_t WS_END = WS_GPART + (size_t)8 * T * 8 * 4;

struct Params { const float* in[23]; float* out; unsigned char* wsp; };
typedef const __attribute__((address_space(4))) Params* KP;
__device__ __forceinline__ KP kparams() { KP p = (KP)__builtin_amdgcn_kernarg_segment_ptr(); asm volatile("" : "+s"(p)); return p; }
#define KIN(i) (kparams()->in[i])
#define KWS (kparams()->wsp)

__device__ __forceinline__ unsigned pk2(float lo, float hi);
__device__ __forceinline__ unsigned f2bf(float f) { return pk2(f, 0.f) & 0xffffu; }
typedef float f32x2_t __attribute__((ext_vector_type(2)));
typedef __bf16 bf16x2_t __attribute__((ext_vector_type(2)));
__device__ __forceinline__ unsigned pk2(float lo, float hi) { f32x2_t v = {lo, hi}; bf16x2_t b = __builtin_convertvector(v, bf16x2_t); return __builtin_bit_cast(unsigned, b); }
__device__ __forceinline__ float bf2f(unsigned short b) { return __builtin_bit_cast(float, (unsigned)b << 16); }
__device__ __forceinline__ float bflo(unsigned w) { return __builtin_bit_cast(float, w << 16); }
__device__ __forceinline__ float bfhi(unsigned w) { return __builtin_bit_cast(float, w & 0xffff0000u); }
__device__ __forceinline__ float sigmoidf_(float x) { return __builtin_amdgcn_rcpf(1.0f + __expf(-x)); }
__device__ __forceinline__ float siluf_(float x) { return x * __builtin_amdgcn_rcpf(1.0f + __expf(-x)); }
__device__ __forceinline__ float wave_sum(float v) {
#pragma unroll
    for (int o = 1; o < 64; o <<= 1) v += __shfl_xor(v, o);
    return v;
}
__device__ __forceinline__ float sum16(float v) { v += __shfl_xor(v, 1); v += __shfl_xor(v, 2); v += __shfl_xor(v, 4); v += __shfl_xor(v, 8); return v; }
__device__ __forceinline__ float max16(float v) { v = fmaxf(v, __shfl_xor(v, 1)); v = fmaxf(v, __shfl_xor(v, 2)); v = fmaxf(v, __shfl_xor(v, 4)); v = fmaxf(v, __shfl_xor(v, 8)); return v; }
__device__ __forceinline__ int launder_i(int x) { asm volatile("" : "+v"(x)); return x; }
#define LBAR() do { asm volatile("s_waitcnt lgkmcnt(0)" ::: "memory"); __builtin_amdgcn_s_barrier(); asm volatile("" ::: "memory"); } while (0)
#define LDS_WAIT() asm volatile("s_waitcnt lgkmcnt(0)" ::: "memory")
__device__ __forceinline__ void unpack8(u32x4 w, float (&f)[8]) {
    f[0] = bflo(w.x); f[1] = bfhi(w.x); f[2] = bflo(w.y); f[3] = bfhi(w.y); f[4] = bflo(w.z); f[5] = bfhi(w.z); f[6] = bflo(w.w); f[7] = bfhi(w.w);
}
__device__ __forceinline__ bf16x8 frag(const LAS bf16_t* base, int ld, int tile, int ks, int lane) {
    return *(const LAS bf16x8*)(base + (tile * 16 + (lane & 15)) * ld + ks * 32 + (lane >> 4) * 8);
}
#define MFMA16(a, b, c) __builtin_amdgcn_mfma_f32_16x16x32_bf16((a), (b), (c), 0, 0, 0)

namespace pg8 {
constexpr int BM = 256, BK = 64, HALF = 128, HTB = HALF * BK * 2, STAGE_BYTES = 8 * HTB, NXCD = 8, WGM = 8;
__device__ __forceinline__ int lds_byte(int r, int c) { const int st = (r >> 4) * 2 + (c >> 5), rr = r & 15, cc = c & 31, ob = rr * 64 + cc * 2; return st * 1024 + (ob ^ (((ob >> 9) & 1) << 5)); }
__device__ __forceinline__ void stage_rc(int b, int& R, int& C) { const int st = b / 1024, sb = b % 1024, swz = sb ^ (((sb >> 9) & 1) << 5); R = (st >> 1) * 16 + swz / 64; C = (st & 1) * 32 + (swz % 64) / 2; }

struct Unit { int pm, pn, z; };
struct Sched {
    const char* A0; const char* B0; int strideA, strideB;
    int nM, nN, nwg, G, c, nz, K;
    __device__ __forceinline__ void init(int M, int N, int K_, int nz_, int G_, int c_) { nM = M / BM; nN = N / BM; nwg = nM * nN; G = G_; c = c_; nz = nz_; K = K_; }
    __device__ __forceinline__ bool next(int i, Unit& u) const {
        const int z = i % nz; const long L = (long)(i / nz) * G + c; if (L >= nwg) return false;
        int wgid = (int)L; { const int q = nwg / NXCD, r = nwg % NXCD, xcd = wgid % NXCD, off = wgid / NXCD; wgid = (xcd < r ? xcd * (q + 1) : r * (q + 1) + (xcd - r) * q) + off; }
        const int nig = WGM * nN, gid = wgid / nig, fm = gid * WGM, gsz = (nM - fm) < WGM ? (nM - fm) : WGM;
        u.pm = fm + ((wgid % nig) % gsz); u.pn = (wgid % nig) / gsz; u.z = z; return true;
    }
    __device__ __forceinline__ const char* abase(const Unit& u) const { return A0 + (size_t)u.z * strideA + (size_t)u.pm * (size_t)BM * K * 2; }
    __device__ __forceinline__ const char* bbase(const Unit& u) const { return B0 + (size_t)u.z * strideB + (size_t)u.pn * (size_t)BM * K * 2; }
};

template <class Epi>
__device__ __forceinline__ void gemm_phase(LAS unsigned char* lds, const Sched& S, const Epi& E) {
    const int tid = launder_i(threadIdx.x), wid = __builtin_amdgcn_readfirstlane(tid >> 6), lane = tid & 63, wr = wid >> 2, wc = wid & 3, fr = lane & 15, fq = lane >> 4;
    const int K = S.K, nt = K / BK;
    unsigned voffA[2], voffB[2];
#pragma unroll
    for (int i = 0; i < 2; ++i) { int R, C; stage_rc(tid * 16 + i * 8192, R, C); const int rho = R & 31, Rb = (R & ~31) + 8 * ((rho & 15) >> 2) + 4 * (rho >> 4) + (rho & 3);
        voffA[i] = (unsigned)(R * K + C) * 2u; voffB[i] = (unsigned)(Rb * K + C) * 2u; }
    const size_t kstep = (size_t)(BK * 2);
    const size_t hstep = (size_t)HALF * K * 2;
    const unsigned ldsw = (unsigned)wid * 1024u;
    const int aoff = lds_byte(wr * 64 + fr, fq * 8), boff = lds_byte(wc * 32 + fr, fq * 8);
#define PG8_SA(b, h) (((b) * 2 + (h)) * HTB)
#define PG8_SB(b, h) ((4 + (b) * 2 + (h)) * HTB)
#define PG8_STAGE2(bufoff, gbase, voff) do { _Pragma("unroll") for (int _i = 0; _i < 2; ++_i) \
        __builtin_amdgcn_global_load_lds((const unsigned*)((const char*)(gbase) + (voff)[_i]), (LAS unsigned*)(lds + (bufoff) + ldsw + _i * 8192), 16, 0, 0); } while (0)
#define PG8_LDA(dst, b, h) do { _Pragma("unroll") for (int m = 0; m < 4; ++m) _Pragma("unroll") for (int k = 0; k < 2; ++k) dst[m][k] = *(const LAS bf16x8*)(lds + PG8_SA(b, h) + aoff + m * 2048 + k * 1024); } while (0)
#define PG8_LDB(dst, b, h) do { _Pragma("unroll") for (int n = 0; n < 2; ++n) _Pragma("unroll") for (int k = 0; k < 2; ++k) dst[n][k] = *(const LAS bf16x8*)(lds + PG8_SB(b, h) + boff + n * 2048 + k * 1024); } while (0)
#define PG8_MMA(ai, bj, At, Bt) do { __builtin_amdgcn_s_setprio(1); _Pragma("unroll") for (int m = 0; m < 4; ++m) _Pragma("unroll") for (int n = 0; n < 2; ++n) _Pragma("unroll") for (int k = 0; k < 2; ++k) \
        acc[ai][bj][m][n] = __builtin_amdgcn_mfma_f32_16x16x32_bf16(Bt[n][k], At[m][k], acc[ai][bj][m][n], 0, 0, 0); __builtin_amdgcn_s_setprio(0); } while (0)
#define PG8_WAIT_V(n) asm volatile("s_waitcnt vmcnt(" #n ")" ::: "memory")
#define PG8_WAIT_L(n) asm volatile("s_waitcnt lgkmcnt(" #n ")" ::: "memory")
#define PG8_BAR __builtin_amdgcn_s_barrier()
#define PG8_SCHED __builtin_amdgcn_sched_barrier(0)
    Unit cur, nxt; int ui = 0;
    if (!S.next(0, cur)) return;
    f32x4 acc[2][2][4][2];
#pragma unroll
    for (int a = 0; a < 2; ++a)
#pragma unroll
        for (int b = 0; b < 2; ++b)
#pragma unroll
            for (int m = 0; m < 4; ++m)
#pragma unroll
                for (int n = 0; n < 2; ++n) acc[a][b][m][n] = (f32x4){0.f, 0.f, 0.f, 0.f};
    bf16x8 At[4][2], B0[2][2], B1[2][2];
    const char* cA = S.abase(cur); const char* cB = S.bbase(cur);
    PG8_STAGE2(PG8_SB(0, 0), cB, voffB); PG8_STAGE2(PG8_SB(0, 1), cB + hstep, voffB); PG8_STAGE2(PG8_SA(0, 0), cA, voffA); PG8_STAGE2(PG8_SA(0, 1), cA + hstep, voffA);
    if (wr == 1) PG8_BAR;
    PG8_WAIT_V(2); PG8_BAR;
    PG8_STAGE2(PG8_SB(1, 0), cB + kstep, voffB); PG8_STAGE2(PG8_SA(1, 0), cA + kstep, voffA); PG8_STAGE2(PG8_SB(1, 1), cB + hstep + kstep, voffB);
    PG8_WAIT_V(6); PG8_BAR;
    for (;;) {
        const bool has_next = S.next(ui + 1, nxt);
        const char* nA = has_next ? S.abase(nxt) : cA; const char* nB = has_next ? S.bbase(nxt) : cB;
        for (int t = 0; t < nt; t += 2) {
            const bool last = (t == nt - 2);
            const char* a1 = cA + (size_t)(t + 1) * kstep;
            const char* a2 = last ? nA : cA + (size_t)(t + 2) * kstep; const char* b2 = last ? nB : cB + (size_t)(t + 2) * kstep;
            const char* a3 = a2 + kstep; const char* b3 = b2 + kstep;
            PG8_LDB(B0, 0, 0); PG8_LDB(B1, 0, 1); PG8_SCHED; PG8_LDA(At, 0, 0); PG8_STAGE2(PG8_SA(1, 1), a1 + hstep, voffA);
            PG8_WAIT_V(8); PG8_WAIT_L(0); PG8_BAR; PG8_MMA(0, 0, At, B0); PG8_MMA(0, 1, At, B1); PG8_BAR; PG8_SCHED;
            PG8_LDA(At, 0, 1); PG8_STAGE2(PG8_SB(0, 0), b2, voffB); PG8_STAGE2(PG8_SB(0, 1), b2 + hstep, voffB); PG8_STAGE2(PG8_SA(0, 0), a2, voffA);
            PG8_WAIT_V(8); PG8_WAIT_L(0); PG8_BAR; PG8_MMA(1, 0, At, B0); PG8_MMA(1, 1, At, B1); PG8_BAR; PG8_SCHED;
            PG8_LDB(B0, 1, 0); PG8_LDB(B1, 1, 1); PG8_SCHED; PG8_LDA(At, 1, 0); PG8_STAGE2(PG8_SA(0, 1), a2 + hstep, voffA);
            PG8_WAIT_V(8); PG8_WAIT_L(0); PG8_BAR; PG8_MMA(0, 0, At, B0); PG8_MMA(0, 1, At, B1); PG8_BAR; PG8_SCHED;
            PG8_LDA(At, 1, 1); PG8_STAGE2(PG8_SB(1, 0), b3, voffB); PG8_STAGE2(PG8_SB(1, 1), b3 + hstep, voffB); PG8_STAGE2(PG8_SA(1, 0), a3, voffA);
            PG8_WAIT_V(8); PG8_WAIT_L(0); PG8_BAR; PG8_MMA(1, 0, At, B0); PG8_MMA(1, 1, At, B1); PG8_BAR; PG8_SCHED;
        }
        if (wr == 0) PG8_BAR;
        if constexpr (!Epi::AFTER_DRAIN) E(acc, cur, wr, wc, fr, fq);
        if (!has_next) break;
        if (!E.keep(cur))
#pragma unroll
        for (int a = 0; a < 2; ++a)
#pragma unroll
            for (int b = 0; b < 2; ++b)
#pragma unroll
                for (int m = 0; m < 4; ++m)
#pragma unroll
                    for (int n = 0; n < 2; ++n) acc[a][b][m][n] = (f32x4){0.f, 0.f, 0.f, 0.f};
        cur = nxt; cA = nA; cB = nB; ++ui;
        if (wr == 1) PG8_BAR;
    }
    PG8_WAIT_V(0);
    PG8_BAR;
    if constexpr (Epi::AFTER_DRAIN) E.fused(acc, cur, wr, wc, fr, fq, lds, wid, lane);
#undef PG8_SA
#undef PG8_SB
#undef PG8_STAGE2
#undef PG8_LDA
#undef PG8_LDB
#undef PG8_MMA
#undef PG8_WAIT_V
#undef PG8_WAIT_L
#undef PG8_BAR
#undef PG8_SCHED
}

struct EpiProj { static constexpr bool AFTER_DRAIN = false;
    bf16_t* O; const float* rope; int pn_off;
    __device__ __forceinline__ bool keep(const Unit&) const { return false; }
    __device__ __forceinline__ void operator()(const f32x4 (&acc)[2][2][4][2], const Unit& u, int wr, int wc, int fr, int fq) const {
        const int pn = u.pn + pn_off;
        const int row0 = u.pm * BM + wr * 64 + fr, col0 = pn * BM + wc * 32 + 8 * fq;
        const bool isrope = (pn >= 16 && pn < 24);
        const float qs = (pn >= 16 && pn < 20) ? 0.18033688011112042f : 1.0f;
#pragma unroll
        for (int ai = 0; ai < 2; ++ai)
#pragma unroll
            for (int m = 0; m < 4; ++m) {
                const int row = row0 + ai * HALF + m * 16;
                bf16_t* rowp = O + (size_t)row * NP + col0;
#pragma unroll
                for (int bj = 0; bj < 2; ++bj) {
                    f32x4 v0 = acc[ai][bj][m][0], v1 = acc[ai][bj][m][1];
                    if (isrope && ((wc & 1) == 0)) {
                        f32x4 p0, p1;
                        p0[0] = __shfl_xor(v0[0], 16); p0[1] = __shfl_xor(v0[1], 16); p0[2] = __shfl_xor(v0[2], 16); p0[3] = __shfl_xor(v0[3], 16);
                        p1[0] = __shfl_xor(v1[0], 16); p1[1] = __shfl_xor(v1[1], 16); p1[2] = __shfl_xor(v1[2], 16); p1[3] = __shfl_xor(v1[3], 16);
                        if (fq < 2) {
                            const f32x4 c0 = *(const f32x4*)(rope + (size_t)row * 16), c1 = *(const f32x4*)(rope + (size_t)row * 16 + 4);
                            const f32x4 s0 = *(const f32x4*)(rope + (size_t)row * 16 + 8), s1 = *(const f32x4*)(rope + (size_t)row * 16 + 12);
                            const float sg = (fq == 0) ? -1.0f : 1.0f;
                            v0 = v0 * c0 + (p0 * s0) * sg; v1 = v1 * c1 + (p1 * s1) * sg;
                        }
                    }
                    if (isrope) { v0 = v0 * qs; v1 = v1 * qs; }
                    u32x4 w; w.x = pk2(v0[0], v0[1]); w.y = pk2(v0[2], v0[3]); w.z = pk2(v1[0], v1[1]); w.w = pk2(v1[2], v1[3]);
                    *(u32x4*)(rowp + bj * HALF) = w;
                    asm volatile("" ::: "memory");
                }
            }
    }
};
struct EpiMerge { static constexpr bool AFTER_DRAIN = false;
    const bf16_t* proj; bf16_t* YB;
    __device__ __forceinline__ bool keep(const Unit& u) const { return u.z < 2; }
    static __device__ __forceinline__ float e1(float x) { return 1.0f + __expf(-fminf(fmaxf(x, -60.f), 60.f)); }
    __device__ __forceinline__ void operator()(f32x4 (&acc)[2][2][4][2], const Unit& u, int wr, int wc, int fr, int fq) const {
        const int row0 = u.pm * BM + wr * 64 + fr, col0 = u.pn * BM + wc * 32 + 8 * fq;
#pragma unroll
        for (int ai = 0; ai < 2; ++ai)
#pragma unroll
            for (int m = 0; m < 4; ++m) {
                const int row = row0 + ai * HALF + m * 16;
#pragma unroll
                for (int bj = 0; bj < 2; ++bj) {
                    const int col = col0 + bj * HALF;
                    const bf16_t* gp = proj + (size_t)row * NP + C_GATE + u.z * D + col;
                    const u32x4 ga = *(const u32x4*)gp;
                    float sc[8];
                    { float a[8]; unpack8(ga, a);
#pragma unroll
                      for (int j = 0; j < 8; ++j) sc[j] = __builtin_amdgcn_rcpf(e1(a[j])); }
                    if (u.z < 2) { const u32x4 gb = *(const u32x4*)(gp + D); float b[8]; unpack8(gb, b);
#pragma unroll
                      for (int j = 0; j < 8; ++j) sc[j] *= e1(b[j]); }
                    f32x4 v0 = acc[ai][bj][m][0], v1 = acc[ai][bj][m][1];
                    v0[0] *= sc[0]; v0[1] *= sc[1]; v0[2] *= sc[2]; v0[3] *= sc[3]; v1[0] *= sc[4]; v1[1] *= sc[5]; v1[2] *= sc[6]; v1[3] *= sc[7];
                    if (u.z < 2) { acc[ai][bj][m][0] = v0; acc[ai][bj][m][1] = v1; }
                    else { u32x4 w; w.x = pk2(v0[0], v0[1]); w.y = pk2(v0[2], v0[3]); w.z = pk2(v1[0], v1[1]); w.w = pk2(v1[2], v1[3]); *(u32x4*)(YB + (size_t)row * D + col) = w; }
                    asm volatile("" ::: "memory");
                }
            }
    }
};
struct EpiResid { static constexpr bool AFTER_DRAIN = false;
    const bf16_t* H; bf16_t* TF;
    __device__ __forceinline__ bool keep(const Unit&) const { return false; }
    __device__ __forceinline__ void operator()(const f32x4 (&acc)[2][2][4][2], const Unit& u, int wr, int wc, int fr, int fq) const {
        const int row0 = u.pm * BM + wr * 64 + fr, col0 = u.pn * BM + wc * 32 + 8 * fq;
#pragma unroll
        for (int ai = 0; ai < 2; ++ai)
#pragma unroll
            for (int m = 0; m < 4; ++m) {
                const int row = row0 + ai * HALF + m * 16;
#pragma unroll
                for (int bj = 0; bj < 2; ++bj) {
                    const size_t o = (size_t)row * D + col0 + bj * HALF;
                    const u32x4 hb = *(const u32x4*)(H + o);
                    const f32x4 h0 = {bflo(hb.x), bfhi(hb.x), bflo(hb.y), bfhi(hb.y)}, h1 = {bflo(hb.z), bfhi(hb.z), bflo(hb.w), bfhi(hb.w)};
                    const f32x4 t0 = h0 * ALPHA + acc[ai][bj][m][0], t1 = h1 * ALPHA + acc[ai][bj][m][1];
                    u32x4 w; w.x = pk2(t0[0], t0[1]); w.y = pk2(t0[2], t0[3]); w.z = pk2(t1[0], t1[1]); w.w = pk2(t1[2], t1[3]);
                    *(u32x4*)(TF + o) = w;
                    asm volatile("" ::: "memory");
                }
            }
    }
};
struct EpiRelu2 { static constexpr bool AFTER_DRAIN = false;
    bf16_t* O;
    __device__ __forceinline__ bool keep(const Unit&) const { return false; }
    __device__ __forceinline__ void operator()(const f32x4 (&acc)[2][2][4][2], const Unit& u, int wr, int wc, int fr, int fq) const {
        const int row0 = u.pm * BM + wr * 64 + fr, col0 = u.pn * BM + wc * 32 + 8 * fq;
#pragma unroll
        for (int ai = 0; ai < 2; ++ai)
#pragma unroll
            for (int m = 0; m < 4; ++m) {
                bf16_t* rowp = O + (size_t)(row0 + ai * HALF + m * 16) * FF + col0;
#pragma unroll
                for (int bj = 0; bj < 2; ++bj) {
                    f32x4 v0 = acc[ai][bj][m][0], v1 = acc[ai][bj][m][1];
                    v0[0] = fmaxf(v0[0], 0.f); v0[1] = fmaxf(v0[1], 0.f); v0[2] = fmaxf(v0[2], 0.f); v0[3] = fmaxf(v0[3], 0.f);
                    v1[0] = fmaxf(v1[0], 0.f); v1[1] = fmaxf(v1[1], 0.f); v1[2] = fmaxf(v1[2], 0.f); v1[3] = fmaxf(v1[3], 0.f);
                    v0 = v0 * v0; v1 = v1 * v1;
                    u32x4 w; w.x = pk2(v0[0], v0[1]); w.y = pk2(v0[2], v0[3]); w.z = pk2(v1[0], v1[1]); w.w = pk2(v1[2], v1[3]);
                    *(u32x4*)(rowp + bj * HALF) = w;
                    asm volatile("" ::: "memory");
                }
            }
    }
};

struct PanelStats8 {
    unsigned long long* xbuf; unsigned* cnt; float eps;
    __device__ __forceinline__ void run(const f32x4 (&v)[2][2][4][2], const Unit& u, int wr, int wc, int fr, int fq, LAS unsigned char* lds, int wid, int lane) const {
        typedef float f32x2v __attribute__((ext_vector_type(2)));
        LAS f32x2v* Pt = (LAS f32x2v*)lds;
        LAS f32x2v* St = (LAS f32x2v*)(lds + 8192);
#pragma unroll
        for (int ai = 0; ai < 2; ++ai)
#pragma unroll
            for (int m = 0; m < 4; ++m) {
                float s = 0.f;
#pragma unroll
                for (int bj = 0; bj < 2; ++bj)
#pragma unroll
                    for (int n = 0; n < 2; ++n) { const f32x4 x = v[ai][bj][m][n]; s += (x[0] + x[1]) + (x[2] + x[3]); }
                s += __shfl_xor(s, 16); s += __shfl_xor(s, 32);
                const float mw = s * (1.0f / 64.0f); float q = 0.f;
#pragma unroll
                for (int bj = 0; bj < 2; ++bj)
#pragma unroll
                    for (int n = 0; n < 2; ++n) { const f32x4 d = v[ai][bj][m][n] - mw; q += (d[0] * d[0] + d[1] * d[1]) + (d[2] * d[2] + d[3] * d[3]); }
                q += __shfl_xor(q, 16); q += __shfl_xor(q, 32);
                if (fq == 0) Pt[(ai * HALF + wr * 64 + m * 16 + fr) * 4 + wc] = (f32x2v){mw, q};
            }
        asm volatile("s_waitcnt lgkmcnt(0)" ::: "memory"); __builtin_amdgcn_s_barrier(); asm volatile("" ::: "memory");
        const int row = wid * 32 + (lane & 31);
        if (lane < 32) {
            const f32x2v a = Pt[row * 4 + 0], b = Pt[row * 4 + 1], c = Pt[row * 4 + 2], d = Pt[row * 4 + 3];
            const float mt = (a.x + b.x + c.x + d.x) * 0.25f;
            const float da = a.x - mt, db = b.x - mt, dc = c.x - mt, dd = d.x - mt;
            const float m2 = (a.y + b.y) + (c.y + d.y) + 64.0f * ((da * da + db * db) + (dc * dc + dd * dd));
            unsigned long long* slot = xbuf + ((size_t)(u.pm * BM + row) * 8 + u.pn);
            __hip_atomic_store(slot, ((unsigned long long)__builtin_bit_cast(unsigned, m2) << 32) | __builtin_bit_cast(unsigned, mt), __ATOMIC_RELAXED, __HIP_MEMORY_SCOPE_AGENT);
        }
        asm volatile("s_waitcnt vmcnt(0)" ::: "memory");
        if (lane == 0) __hip_atomic_fetch_add(cnt + 64 * u.pm, 1u, __ATOMIC_RELAXED, __HIP_MEMORY_SCOPE_AGENT);
        if (wid == 0) {
            unsigned spins = 0;
            for (;;) {
                if ((unsigned)__builtin_amdgcn_readfirstlane(__hip_atomic_load(cnt + 64 * u.pm, __ATOMIC_RELAXED, __HIP_MEMORY_SCOPE_AGENT)) >= 64u) break;
                if (++spins > (1u << 22)) break;
            }
            __builtin_amdgcn_fence(__ATOMIC_ACQUIRE, "agent");
        }
        asm volatile("s_waitcnt vmcnt(0) lgkmcnt(0)" ::: "memory"); __builtin_amdgcn_s_barrier(); asm volatile("" ::: "memory");
        if (lane < 32) {
            const unsigned long long* slot = xbuf + (size_t)(u.pm * BM + row) * 8; float mt[8], m2[8]; float ms = 0.f;
#pragma unroll
            for (int t = 0; t < 8; ++t) { const unsigned long long w = __hip_atomic_load(slot + t, __ATOMIC_RELAXED, __HIP_MEMORY_SCOPE_AGENT); mt[t] = __builtin_bit_cast(float, (unsigned)w); m2[t] = __builtin_bit_cast(float, (unsigned)(w >> 32)); ms += mt[t]; }
            const float mean = ms * 0.125f; float q = 0.f;
#pragma unroll
            for (int t = 0; t < 8; ++t) { const float dm = mt[t] - mean; q += m2[t] + 256.0f * dm * dm; }
            St[row] = (f32x2v){mean, 1.0f / sqrtf(q * (1.0f / 2048.0f) + eps)};
        }
        asm volatile("s_waitcnt lgkmcnt(0)" ::: "memory"); __builtin_amdgcn_s_barrier(); asm volatile("" ::: "memory");
    }
};
template <bool OUT_F32, bool GATES>
struct EpiLn { static constexpr bool AFTER_DRAIN = true; static constexpr int DRAIN = 0;
    const bf16_t* H; const float* w; const float* b; bf16_t* outB; float* outF; PanelStats8 st;
    const float* win_next; const float* gbias; float* gpart;
    __device__ __forceinline__ bool keep(const Unit&) const { return false; }
    __device__ __forceinline__ void fused(f32x4 (&acc)[2][2][4][2], const Unit& u, int wr, int wc, int fr, int fq, LAS unsigned char* lds, int wid, int lane) const {
        typedef float f32x2v __attribute__((ext_vector_type(2)));
        const LAS f32x2v* St = (const LAS f32x2v*)(lds + 8192);
        const int col0 = u.pn * BM + wc * 32 + 8 * fq;
#pragma unroll
        for (int ai = 0; ai < 2; ++ai)
#pragma unroll
            for (int m = 0; m < 4; ++m) {
                const size_t ro = (size_t)(u.pm * BM + ai * HALF + wr * 64 + m * 16 + fr) * D + col0;
#pragma unroll
                for (int bj = 0; bj < 2; ++bj) {
                    const u32x4 hb = *(const u32x4*)(H + ro + bj * HALF);
                    const f32x4 h0 = {bflo(hb.x), bfhi(hb.x), bflo(hb.y), bfhi(hb.y)}, h1 = {bflo(hb.z), bfhi(hb.z), bflo(hb.w), bfhi(hb.w)};
                    acc[ai][bj][m][0] = h0 * ALPHA + acc[ai][bj][m][0]; acc[ai][bj][m][1] = h1 * ALPHA + acc[ai][bj][m][1];
                }
                if (m & 1) asm volatile("" ::: "memory");
            }
        if (GATES) {
            LAS float* wgl = (LAS float*)(lds + 16384);
            const int tid_ = wid * 64 + lane;
            if (tid_ < 256) { const float* src = win_next + (size_t)(u.pn * BM + tid_) * NSRC + 4096; const f32x4 a = *(const f32x4*)src, c = *(const f32x4*)(src + 4);
                wgl[0 * 256 + tid_] = a[0]; wgl[1 * 256 + tid_] = a[1]; wgl[2 * 256 + tid_] = a[2]; wgl[3 * 256 + tid_] = a[3];
                wgl[4 * 256 + tid_] = c[0]; wgl[5 * 256 + tid_] = c[1]; wgl[6 * 256 + tid_] = c[2]; wgl[7 * 256 + tid_] = c[3]; }
        }
        st.run(acc, u, wr, wc, fr, fq, lds, wid, lane);
#pragma unroll
        for (int bj = 0; bj < 2; ++bj) {
            const f32x4 w0 = *(const f32x4*)(w + col0 + bj * HALF), w1 = *(const f32x4*)(w + col0 + bj * HALF + 4);
            const f32x4 b0 = *(const f32x4*)(b + col0 + bj * HALF), b1 = *(const f32x4*)(b + col0 + bj * HALF + 4);
#pragma unroll
            for (int ai = 0; ai < 2; ++ai)
#pragma unroll
                for (int m = 0; m < 4; ++m) {
                    const int r = ai * HALF + wr * 64 + m * 16 + fr; const f32x2v sr = St[r];
                    const size_t o = (size_t)(u.pm * BM + r) * D + col0 + bj * HALF;
                    const f32x4 o0 = ((acc[ai][bj][m][0] - sr.x) * sr.y) * w0 + b0, o1 = ((acc[ai][bj][m][1] - sr.x) * sr.y) * w1 + b1;
                    if (OUT_F32) { *(f32x4*)(outF + o) = o0; *(f32x4*)(outF + o + 4) = o1; }
                    else { u32x4 pw; pw.x = pk2(o0[0], o0[1]); pw.y = pk2(o0[2], o0[3]); pw.z = pk2(o1[0], o1[1]); pw.w = pk2(o1[2], o1[3]); *(u32x4*)(outB + o) = pw; }
                    if (GATES) { acc[ai][bj][m][0] = o0; acc[ai][bj][m][1] = o1; }
                    asm volatile("" ::: "memory");
                }
        }
        if (GATES) {
            const LAS float* wgl = (const LAS float*)(lds + 16384);
            LAS float* GP = (LAS float*)(lds + 32768);
#pragma unroll 1
            for (int g = 0; g < 8; ++g) {
                const LAS float* wq = wgl + g * 256 + wc * 32 + 8 * fq;
                const f32x4 q00 = *(const LAS f32x4*)(wq), q01 = *(const LAS f32x4*)(wq + 4), q10 = *(const LAS f32x4*)(wq + HALF), q11 = *(const LAS f32x4*)(wq + HALF + 4);
#pragma unroll
                for (int ai = 0; ai < 2; ++ai)
#pragma unroll
                    for (int m = 0; m < 4; ++m) {
                        const f32x4 a0 = acc[ai][0][m][0] * q00 + acc[ai][0][m][1] * q01 + acc[ai][1][m][0] * q10 + acc[ai][1][m][1] * q11;
                        float p = (a0[0] + a0[1]) + (a0[2] + a0[3]);
                        p += __shfl_xor(p, 16); p += __shfl_xor(p, 32);
                        if (fq == 0) GP[((ai * HALF + wr * 64 + m * 16 + fr) * 8 + g) * 4 + wc] = p;
                    }
            }
            asm volatile("s_waitcnt lgkmcnt(0)" ::: "memory"); __builtin_amdgcn_s_barrier(); asm volatile("" ::: "memory");
            const int tid_ = wid * 64 + lane;
#pragma unroll
            for (int i = 0; i < 4; ++i) {
                const int idx = tid_ + 512 * i, row = idx >> 3, g = idx & 7;
                const f32x4 pp = *(const LAS f32x4*)(GP + idx * 4);
                float v = (pp[0] + pp[1]) + (pp[2] + pp[3]);
                if (u.pn == 0) v += gbias[g];
                gpart[(size_t)u.pn * T * 8 + (size_t)(u.pm * BM + row) * 8 + g] = v;
            }
        }
    }
};
}

__device__ __forceinline__ void tr_item(const float* W, int ldw, int src_c0, bf16_t* WT, int K, int n0, int k0, LAS float* scr, int lane) {
    const int r4 = lane >> 4, c4 = (lane & 15) * 4;
#pragma unroll 8
    for (int it = 0; it < 16; ++it) { const int kk = 4 * it + r4; const f32x4 v = __builtin_nontemporal_load((const f32x4*)(W + (size_t)(k0 + kk) * ldw + src_c0 + c4));
        LAS float* d = scr + kk * 65 + c4; d[0] = v[0]; d[1] = v[1]; d[2] = v[2]; d[3] = v[3]; }
    LDS_WAIT();
    const int c = lane & 7;
#pragma unroll
    for (int j = 0; j < 8; ++j) { const int n = (lane >> 3) + 8 * j; const LAS float* s = scr + (8 * c) * 65 + n;
        u32x4 o; o.x = pk2(s[0 * 65], s[1 * 65]); o.y = pk2(s[2 * 65], s[3 * 65]); o.z = pk2(s[4 * 65], s[5 * 65]); o.w = pk2(s[6 * 65], s[7 * 65]);
        *(u32x4*)(WT + (size_t)(n0 + n) * K + k0 + 8 * c) = o; }
    LDS_WAIT();
}
__device__ __forceinline__ void tr_matrix_item(const float* W, int K, int N, int ldw, bool skip8, bf16_t* WT, int item, LAS float* scr, int lane) {
    const int nblk = N / 64, kb = item / nblk, nb = item % nblk, n0 = nb * 64;
    const int src = n0 + ((skip8 && n0 >= 4096) ? 8 : 0);
    tr_item(W, ldw, src, WT, K, n0, kb * 64, scr, lane);
}

template <bool GATES, bool WRITE_B, bool WRITE_F, bool SRC_BF16>
__device__ __forceinline__ void ln_phase(const float* src, const float* w, const float* b, float* dstF, bf16_t* dstB,
                                         const float* win_l  , const float* gate_b, float* gif, LAS unsigned char* lds, int G) {
    const int tid = launder_i(threadIdx.x), lane = tid & 63, wid = tid >> 6;
    LAS float* wg = (LAS float*)lds;
    if (GATES) {
        for (int k = tid; k < D; k += NTHREADS) {
            const f32x4 a = *(const f32x4*)(win_l + (size_t)k * NSRC + 4096), c = *(const f32x4*)(win_l + (size_t)k * NSRC + 4100);
            wg[0 * D + k] = a[0]; wg[1 * D + k] = a[1]; wg[2 * D + k] = a[2]; wg[3 * D + k] = a[3];
            wg[4 * D + k] = c[0]; wg[5 * D + k] = c[1]; wg[6 * D + k] = c[2]; wg[7 * D + k] = c[3];
        }
        __syncthreads();
    }
    const int rstep = G * NWAVES, row_first = blockIdx.x * NWAVES + wid;
    u32x2 rawb[8]; f32x4 rawf[8];
    if (row_first < T) {
#pragma unroll
        for (int j = 0; j < 8; ++j) { if (SRC_BF16) rawb[j] = *(const u32x2*)((const bf16_t*)src + (size_t)row_first * D + 256 * j + 4 * lane); else rawf[j] = *(const f32x4*)(src + (size_t)row_first * D + 256 * j + 4 * lane); }
    }
    for (int row = row_first; row < T; row += rstep) {
        f32x4 v[8]; float s = 0.f;
#pragma unroll
        for (int j = 0; j < 8; ++j) {
            if (SRC_BF16) v[j] = (f32x4){bflo(rawb[j].x), bfhi(rawb[j].x), bflo(rawb[j].y), bfhi(rawb[j].y)}; else v[j] = rawf[j];
            s += (v[j][0] + v[j][1]) + (v[j][2] + v[j][3]);
        }
        if (row + rstep < T) {
#pragma unroll
            for (int j = 0; j < 8; ++j) { if (SRC_BF16) rawb[j] = *(const u32x2*)((const bf16_t*)src + (size_t)(row + rstep) * D + 256 * j + 4 * lane); else rawf[j] = *(const f32x4*)(src + (size_t)(row + rstep) * D + 256 * j + 4 * lane); }
        }
        const float mean = wave_sum(s) * (1.0f / D); float s2 = 0.f;
#pragma unroll
        for (int j = 0; j < 8; ++j) { v[j] = v[j] - mean; s2 += (v[j][0] * v[j][0] + v[j][1] * v[j][1]) + (v[j][2] * v[j][2] + v[j][3] * v[j][3]); }
        const float rstd = 1.0f / sqrtf(wave_sum(s2) * (1.0f / D) + LN_EPS);
#pragma unroll
        for (int j = 0; j < 8; ++j) {
            const f32x4 wvj = *(const f32x4*)(w + 256 * j + 4 * lane), bvj = *(const f32x4*)(b + 256 * j + 4 * lane);
            v[j] = (v[j] * rstd) * wvj + bvj;
            if (WRITE_F) *(f32x4*)(dstF + (size_t)row * D + 256 * j + 4 * lane) = v[j];
            if (WRITE_B) { u32x2 o; o.x = pk2(v[j][0], v[j][1]); o.y = pk2(v[j][2], v[j][3]); *(u32x2*)(dstB + (size_t)row * D + 256 * j + 4 * lane) = o; }
        }
        if (GATES) {
            float mine = 0.f;
#pragma unroll 1
            for (int g = 0; g < 8; ++g) {
                float p = 0.f;
#pragma unroll
                for (int j = 0; j < 8; ++j) { const f32x4 q = *(const LAS f32x4*)(wg + g * D + 256 * j + 4 * lane); p += (v[j][0] * q[0] + v[j][1] * q[1]) + (v[j][2] * q[2] + v[j][3] * q[3]); }
                p = wave_sum(p);
                if (lane == g) mine = p + gate_b[g];
            }
            if (lane < 8) gif[(size_t)row * 8 + lane] = mine;
        }
    }
    if (GATES) __syncthreads();
}

typedef short v4i16_t __attribute__((ext_vector_type(4)));
__device__ __forceinline__ bf16x8 trfrag2(const LAS bf16_t* p0, const LAS bf16_t* p1) {
    const v4i16_t a = __builtin_amdgcn_ds_read_tr16_b64_v4i16((LAS v4i16_t*)p0), b = __builtin_amdgcn_ds_read_tr16_b64_v4i16((LAS v4i16_t*)p1);
    bf16x8 r; r[0] = a[0]; r[1] = a[1]; r[2] = a[2]; r[3] = a[3]; r[4] = b[0]; r[5] = b[1]; r[6] = b[2]; r[7] = b[3]; return r;
}
__device__ __forceinline__ bf16x8 trfrag(const LAS bf16_t* base, int ld, int row0, int col0, int lane) {
    const int g = lane >> 4, q = (lane & 15) >> 2, p = lane & 3;
    const LAS bf16_t* p0 = base + (row0 + 8 * g + q) * ld + col0 + 4 * p;
    return trfrag2(p0, p0 + 4 * ld);
}

__device__ __forceinline__ void mlstm_unit(int unit, int l, const bf16_t* proj, const float* gif, const float* conv_w, const float* conv_b, bf16_t* mpart, float* dpart, int gplanes, LAS unsigned char* lds) {
    const int tid = launder_i(threadIdx.x), lane = tid & 63, wid = __builtin_amdgcn_readfirstlane(tid >> 6);
    const int b = unit >> 4, h = (unit >> 2) & 3, dq = unit & 3;
    const int g = lane >> 4, c16 = lane & 15;
    LAS bf16_t* Q = (LAS bf16_t*)(lds);
    LAS bf16_t* KK = (LAS bf16_t*)(lds + 9216);
    LAS bf16_t* V1 = (LAS bf16_t*)(lds + 18432);
    LAS bf16_t* VW = (LAS bf16_t*)(lds + 52224);
    LAS bf16_t* ST = (LAS bf16_t*)(lds + 86016);
    LAS bf16_t* AS = (LAS bf16_t*)(lds + 122880);
    LAS float* CWL = (LAS float*)(lds + 132096);
    LAS float* tabs = (LAS float*)(lds + 134656);
    LAS float* nvec = tabs + 384;
    LAS float* dsum = nvec + 64;
    LAS float* qn = dsum + 128;
    LAS float* npart = qn + 64;
    for (int i = tid; i < 256 * 72 / 2; i += NTHREADS) ((LAS unsigned*)ST)[i] = 0u;
    if (tid < 64) nvec[tid] = 0.f;
    if (tid < 128) {
        const float* cw = conv_w + (size_t)l * 4 * 2048; const float* cb = conv_b + (size_t)l * 2048;
        const int gcol = (tid >> 6) * 1024 + h * 256 + dq * 64 + (tid & 63);
#pragma unroll
        for (int tap = 0; tap < 4; ++tap) CWL[tap * 128 + tid] = cw[tap * 2048 + gcol];
        CWL[4 * 128 + tid] = cb[gcol];
    }
    f32x4 ct[2][4];
#pragma unroll
    for (int a = 0; a < 2; ++a)
#pragma unroll
        for (int n = 0; n < 4; ++n) ct[a][n] = (f32x4){0.f, 0.f, 0.f, 0.f};
    const int dgi = tid & 15, run = tid >> 4, lcol = (dgi >> 3) * 1024 + h * 256 + dq * 64 + (dgi & 7) * 8;
    const bf16_t* pq = proj + ((size_t)b * SEQ + run * 2 - 3) * NP + lcol;
    const bf16_t* pv = proj + ((size_t)b * SEQ + (tid >> 3)) * NP + C_MV + h * 256 + (tid & 7) * 8;
    const float* pg = gif + ((size_t)b * SEQ + lane) * 8 + h;
    u32x4 pf[5], pfv[4]; float pfi = 0.f, pff = 0.f; float pgi7[7] = {0.f, 0.f, 0.f, 0.f, 0.f, 0.f, 0.f}, pgf7[7] = {0.f, 0.f, 0.f, 0.f, 0.f, 0.f, 0.f};
#pragma unroll
    for (int i = 0; i < 5; ++i) { if (run * 2 - 3 + i < 0) pf[i] = (u32x4){0u, 0u, 0u, 0u}; else pf[i] = *(const u32x4*)(pq + (size_t)i * NP); }
#pragma unroll
    for (int i = 0; i < 4; ++i) pfv[i] = *(const u32x4*)(pv + 64 * i);
    if (wid == 0) {
        float ipre = pg[0], fpre = pg[4];
        if (gplanes == 8) {
            float gi_[7], gf_[7];
#pragma unroll
            for (int gp = 0; gp < 7; ++gp) { gi_[gp] = pg[(size_t)(gp + 1) * T * 8]; gf_[gp] = pg[(size_t)(gp + 1) * T * 8 + 4]; }
#pragma unroll
            for (int gp = 0; gp < 7; ++gp) { ipre += gi_[gp]; fpre += gf_[gp]; }
        }
        float v = fminf(fpre, 0.f) - __logf(1.0f + __expf(-fabsf(fpre)));
#pragma unroll
        for (int off = 1; off < 64; off <<= 1) { const float tv = __shfl_up(v, off); if (lane >= off) v += tv; }
        const float Gc = __shfl(v, 63);
        tabs[lane] = v; tabs[64 + lane] = ipre; tabs[128 + lane] = __expf(Gc - v + ipre) * 0.0625f;
    }
    __syncthreads();
    for (int c = 0; c < SEQ / 64; ++c) {
        const int t0 = c * 64; const size_t rowbase = (size_t)b * SEQ + t0;
        const LAS float* bcum = tabs + (c & 1) * 192; const LAS float* ig = bcum + 64; const LAS float* wsc = bcum + 128;
        const float Gc = bcum[63];
        {
            float cwr[5][8];
#pragma unroll
            for (int tap = 0; tap < 5; ++tap) { const f32x4 a = *(const LAS f32x4*)(CWL + tap * 128 + dgi * 8), c2 = *(const LAS f32x4*)(CWL + tap * 128 + dgi * 8 + 4);
                cwr[tap][0] = a[0]; cwr[tap][1] = a[1]; cwr[tap][2] = a[2]; cwr[tap][3] = a[3]; cwr[tap][4] = c2[0]; cwr[tap][5] = c2[1]; cwr[tap][6] = c2[2]; cwr[tap][7] = c2[3]; }
            LAS bf16_t* dst = ((dgi >> 3) ? KK : Q) + (run * 2) * 72 + (dgi & 7) * 8;
#pragma unroll
            for (int i = 0; i < 2; ++i) {
                float a[8];
#pragma unroll
                for (int j = 0; j < 8; ++j) a[j] = cwr[4][j];
#pragma unroll
                for (int tap = 0; tap < 4; ++tap) { float xf[8]; unpack8(pf[i + tap], xf);
#pragma unroll
                    for (int j = 0; j < 8; ++j) a[j] += cwr[tap][j] * xf[j]; }
#pragma unroll
                for (int j = 0; j < 8; ++j) a[j] = siluf_(a[j]);
                u32x4 o; o.x = pk2(a[0], a[1]); o.y = pk2(a[2], a[3]); o.z = pk2(a[4], a[5]); o.w = pk2(a[6], a[7]);
                *(LAS u32x4*)(dst + i * 72) = o;
            }
            if (c > 0 && tid < 64) {
                float sn = 0.f;
#pragma unroll
                for (int w8 = 0; w8 < 8; ++w8) sn += npart[w8 * 64 + tid];
                nvec[tid] = __expf(tabs[((c - 1) & 1) * 192 + 63]) * nvec[tid] + sn;
            }
            const int tv = tid >> 3, eg = tid & 7; const float w = wsc[tv];
#pragma unroll
            for (int i = 0; i < 4; ++i) {
                *(LAS u32x4*)(V1 + tv * 264 + (eg + 8 * i) * 8) = pfv[i];
                float vf[8]; unpack8(pfv[i], vf);
                u32x4 o; o.x = pk2(vf[0] * w, vf[1] * w); o.y = pk2(vf[2] * w, vf[3] * w); o.z = pk2(vf[4] * w, vf[5] * w); o.w = pk2(vf[6] * w, vf[7] * w);
                *(LAS u32x4*)(VW + tv * 264 + (eg + 8 * i) * 8) = o;
            }
        }
        LBAR();
        if (c + 1 < SEQ / 64) {
            pq += (size_t)64 * NP; pv += (size_t)64 * NP; pg += 64 * 8;
#pragma unroll
            for (int i = 0; i < 5; ++i) pf[i] = *(const u32x4*)(pq + (size_t)i * NP);
#pragma unroll
            for (int i = 0; i < 4; ++i) pfv[i] = *(const u32x4*)(pv + 64 * i);
            if (wid == 0) { pfi = pg[0]; pff = pg[4];
                if (gplanes == 8) {
#pragma unroll
                    for (int gp = 0; gp < 7; ++gp) { pgi7[gp] = pg[(size_t)(gp + 1) * T * 8]; pgf7[gp] = pg[(size_t)(gp + 1) * T * 8 + 4]; }
                } }
        }
        {
            const int mt = wid >> 1, nt0 = (wid & 1) * 2;
            f32x4 s0 = {0.f, 0.f, 0.f, 0.f}, s1 = {0.f, 0.f, 0.f, 0.f};
#pragma unroll
            for (int ks = 0; ks < 2; ++ks) { const bf16x8 a = frag(Q, 72, mt, ks, lane); s0 = MFMA16(a, frag(KK, 72, nt0, ks, lane), s0); s1 = MFMA16(a, frag(KK, 72, nt0 + 1, ks, lane), s1); }
            float rs[4];
#pragma unroll
            for (int j = 0; j < 4; ++j) {
                const int t = 16 * mt + 4 * g + j; const float bt = bcum[t];
                const int sa = 16 * nt0 + c16, sb = sa + 16;
                const float va = (sa <= t) ? s0[j] * __expf(bt - bcum[sa] + ig[sa]) * 0.0625f : 0.f;
                const float vb = (sb <= t) ? s1[j] * __expf(bt - bcum[sb] + ig[sb]) * 0.0625f : 0.f;
                AS[t * 72 + sa] = (bf16_t)f2bf(va); AS[t * 72 + sb] = (bf16_t)f2bf(vb);
                rs[j] = sum16(va + vb);
            }
            if (c16 == 0) {
#pragma unroll
                for (int j = 0; j < 4; ++j) dsum[(wid & 1) * 64 + 16 * mt + 4 * g + j] = rs[j];
            }
            const int t = tid >> 3, part = tid & 7; float p = 0.f;
            { const u32x4 qv = *(const LAS u32x4*)(Q + t * 72 + part * 8); float qf[8]; unpack8(qv, qf);
#pragma unroll
              for (int j = 0; j < 8; ++j) p += qf[j] * nvec[part * 8 + j]; }
            p += __shfl_xor(p, 1); p += __shfl_xor(p, 2); p += __shfl_xor(p, 4);
            if (part == 0) qn[t] = p;
        }
        LBAR();
        {
            f32x4 o1[2][4], o2[2][4];
#pragma unroll
            for (int ei = 0; ei < 2; ++ei)
#pragma unroll
                for (int tt = 0; tt < 4; ++tt) { o1[ei][tt] = (f32x4){0.f, 0.f, 0.f, 0.f}; o2[ei][tt] = (f32x4){0.f, 0.f, 0.f, 0.f}; }
#pragma unroll
            for (int ks = 0; ks < 2; ++ks) {
                const bf16x8 av0 = trfrag(V1, 264, 32 * ks, 16 * (2 * wid), lane), av1 = trfrag(V1, 264, 32 * ks, 16 * (2 * wid + 1), lane);
                const bf16x8 as0 = frag(ST, 72, 2 * wid, ks, lane), as1 = frag(ST, 72, 2 * wid + 1, ks, lane);
#pragma unroll
                for (int tt = 0; tt < 4; ++tt) {
                    const bf16x8 ba = frag(AS, 72, tt, ks, lane), bq = frag(Q, 72, tt, ks, lane);
                    o1[0][tt] = MFMA16(av0, ba, o1[0][tt]); o1[1][tt] = MFMA16(av1, ba, o1[1][tt]);
                    o2[0][tt] = MFMA16(as0, bq, o2[0][tt]); o2[1][tt] = MFMA16(as1, bq, o2[1][tt]);
                }
            }
#pragma unroll
            for (int tt = 0; tt < 4; ++tt) {
                const int t = 16 * tt + c16; const float wI = __expf(bcum[t]);
                bf16_t* orow = mpart + (rowbase + t) * 1024 + h * 256 + 32 * wid + 4 * g;
                const f32x4 r0 = o1[0][tt] + o2[0][tt] * wI, r1 = o1[1][tt] + o2[1][tt] * wI;
                u32x2 w0, w1; w0.x = pk2(r0[0], r0[1]); w0.y = pk2(r0[2], r0[3]); w1.x = pk2(r1[0], r1[1]); w1.y = pk2(r1[2], r1[3]);
                *(u32x2*)(orow) = w0; *(u32x2*)(orow + 16) = w1;
            }
            if (tid < 64) dpart[(rowbase + tid) * 4 + h] = dsum[tid] + dsum[64 + tid] + __expf(bcum[tid]) * qn[tid];
        }
        {
            const float dec = __expf(Gc);
#pragma unroll
            for (int a = 0; a < 2; ++a)
#pragma unroll
                for (int n = 0; n < 4; ++n) ct[a][n] = ct[a][n] * dec;
#pragma unroll
            for (int ks = 0; ks < 2; ++ks) {
                const bf16x8 a0 = trfrag(VW, 264, 32 * ks, 16 * (2 * wid), lane), a1 = trfrag(VW, 264, 32 * ks, 16 * (2 * wid + 1), lane);
#pragma unroll
                for (int n = 0; n < 4; ++n) { const bf16x8 bk = trfrag(KK, 72, 32 * ks, 16 * n, lane); ct[0][n] = MFMA16(a0, bk, ct[0][n]); ct[1][n] = MFMA16(a1, bk, ct[1][n]); }
            }
#pragma unroll
            for (int a = 0; a < 2; ++a)
#pragma unroll
                for (int n = 0; n < 4; ++n)
#pragma unroll
                    for (int j = 0; j < 4; ++j) ST[(16 * (2 * wid + a) + 4 * g + j) * 72 + 16 * n + c16] = (bf16_t)f2bf(ct[a][n][j]);
            {
                float sn = 0.f;
#pragma unroll
                for (int i = 0; i < 8; ++i) sn += wsc[wid * 8 + i] * bf2f(KK[(wid * 8 + i) * 72 + lane]);
                npart[wid * 64 + lane] = sn;
            }
            if (wid == 0 && c + 1 < SEQ / 64) {
                LAS float* nb = tabs + ((c + 1) & 1) * 192;
#pragma unroll
                for (int gp = 0; gp < 7; ++gp) { pfi += pgi7[gp]; pff += pgf7[gp]; }
                float v = fminf(pff, 0.f) - __logf(1.0f + __expf(-fabsf(pff)));
#pragma unroll
                for (int off = 1; off < 64; off <<= 1) { const float tv = __shfl_up(v, off); if (lane >= off) v += tv; }
                const float Gn = __shfl(v, 63);
                nb[lane] = v; nb[64 + lane] = pfi; nb[128 + lane] = __expf(Gn - v + pfi) * 0.0625f;
            }
        }
        LBAR();
    }
}

__device__ __forceinline__ void hgrn_unit(int unit, int l, const bf16_t* proj, const float* lb_logits, bf16_t* hpart, LAS unsigned char* lds) {
    const int tid = launder_i(threadIdx.x), lane = tid & 63, wid = __builtin_amdgcn_readfirstlane(tid >> 6);
    const int b = unit >> 4, h = (unit >> 1) & 7, kh = unit & 1;
    const int g = lane >> 4, c16 = lane & 15;
    LAS bf16_t* QA = (LAS bf16_t*)(lds);
    LAS bf16_t* KA = (LAS bf16_t*)(lds + 4608);
    LAS bf16_t* KB = (LAS bf16_t*)(lds + 9216);
    LAS bf16_t* VV = (LAS bf16_t*)(lds + 13824);
    LAS bf16_t* AS = (LAS bf16_t*)(lds + 22528);
    LAS bf16_t* ST = (LAS bf16_t*)(lds + 25088);
    LAS float* GD = (LAS float*)(lds + 43520);
    for (int i = tid; i < 128 * 72 / 2; i += NTHREADS) ((LAS unsigned*)ST)[i] = 0u;
    f32x4 st[4];
#pragma unroll
    for (int n = 0; n < 4; ++n) st[n] = (f32x4){0.f, 0.f, 0.f, 0.f};
    const int t = lane & 31, kg = tid >> 5;
    float lbv[4];
#pragma unroll
    for (int j = 0; j < 4; ++j) {
        const int ch = h * 128 + kh * 64 + kg * 4 + j;
        lbv[j] = (l == 0) ? 0.f : 1.0f / (1.0f + expf(lb_logits[ch] - lb_logits[1024 + ch]));
    }
    const bf16_t* pb = proj + ((size_t)b * SEQ + t) * NP + h * 128;
    u32x2 pgf = *(const u32x2*)(pb + C_GF + kh * 64 + kg * 4), pgq = *(const u32x2*)(pb + C_GQ + kh * 64 + kg * 4); u32x4 pgi = *(const u32x4*)(pb + C_GI + kg * 8);
    __syncthreads();
    for (int c = 0; c < SEQ / 32; ++c) {
        {
            float gf[4] = {bflo(pgf.x), bfhi(pgf.x), bflo(pgf.y), bfhi(pgf.y)}, qf[4] = {bflo(pgq.x), bfhi(pgq.x), bflo(pgq.y), bfhi(pgq.y)};
            float lf[4], kk[4], qa[4], ka[4], kb[4];
#pragma unroll
            for (int j = 0; j < 4; ++j) { const float f = lbv[j] + (1.0f - lbv[j]) * sigmoidf_(gf[j]); lf[j] = __logf(fmaxf(f, 1e-30f)); kk[j] = 1.0f - f; }
#pragma unroll
            for (int off = 1; off < 32; off <<= 1)
#pragma unroll
                for (int j = 0; j < 4; ++j) { const float v = __shfl_up(lf[j], off, 32); if (t >= off) lf[j] += v; }
#pragma unroll
            for (int j = 0; j < 4; ++j) {
                const float Gk = __shfl(lf[j], 31, 32);
                qa[j] = siluf_(qf[j]) * __expf(lf[j]); ka[j] = kk[j] * __expf(fminf(-lf[j], 80.f)); kb[j] = kk[j] * __expf(Gk - lf[j]);
                if (t == 31) GD[kg * 4 + j] = __expf(Gk);
            }
            u32x2 o; o.x = pk2(qa[0], qa[1]); o.y = pk2(qa[2], qa[3]); *(LAS u32x2*)(QA + t * 72 + kg * 4) = o;
            o.x = pk2(ka[0], ka[1]); o.y = pk2(ka[2], ka[3]); *(LAS u32x2*)(KA + t * 72 + kg * 4) = o;
            o.x = pk2(kb[0], kb[1]); o.y = pk2(kb[2], kb[3]); *(LAS u32x2*)(KB + t * 72 + kg * 4) = o;
            *(LAS u32x4*)(VV + t * 136 + kg * 8) = pgi;
        }
        LBAR();
        if (c + 1 < SEQ / 32) { pb += (size_t)32 * NP; pgf = *(const u32x2*)(pb + C_GF + kh * 64 + kg * 4); pgq = *(const u32x2*)(pb + C_GQ + kh * 64 + kg * 4); pgi = *(const u32x4*)(pb + C_GI + kg * 8); }
        if (wid < 4) {
            const int mt = wid >> 1, nt = wid & 1; f32x4 s = {0.f, 0.f, 0.f, 0.f};
#pragma unroll
            for (int ks = 0; ks < 2; ++ks) s = MFMA16(frag(QA, 72, mt, ks, lane), frag(KA, 72, nt, ks, lane), s);
#pragma unroll
            for (int j = 0; j < 4; ++j) { const int tt = 16 * mt + 4 * g + j, ss = 16 * nt + c16; AS[tt * 40 + ss] = (bf16_t)f2bf(ss <= tt ? s[j] : 0.f); }
        }
        LBAR();
        const bf16x8 vfr = trfrag(VV, 136, 0, 16 * wid, lane);
        {
#pragma unroll
            for (int mt = 0; mt < 2; ++mt) {
                f32x4 a = {0.f, 0.f, 0.f, 0.f};
                a = MFMA16(vfr, frag(AS, 40, mt, 0, lane), a);
#pragma unroll
                for (int ks = 0; ks < 2; ++ks) a = MFMA16(frag(ST, 72, wid, ks, lane), frag(QA, 72, mt, ks, lane), a);
                { u32x2 w; w.x = pk2(a[0], a[1]); w.y = pk2(a[2], a[3]); *(u32x2*)(hpart + ((size_t)b * SEQ + c * 32 + 16 * mt + c16) * 1024 + h * 128 + 16 * wid + 4 * g) = w; }
            }
        }
        {
#pragma unroll
            for (int n = 0; n < 4; ++n) {
                const float dec = GD[16 * n + c16];
                st[n] = st[n] * dec;
                st[n] = MFMA16(vfr, trfrag(KB, 72, 0, 16 * n, lane), st[n]);
#pragma unroll
                for (int j = 0; j < 4; ++j) ST[(16 * wid + 4 * g + j) * 72 + 16 * n + c16] = (bf16_t)f2bf(st[n][j]);
            }
        }
        LBAR();
    }
}

__device__ __forceinline__ void attn_unit(int u, int l, const bf16_t* proj, const float* a_lambda, const float* a_norm_w, bf16_t* ha, LAS unsigned char* lds) {
    const int tid = launder_i(threadIdx.x), lane = tid & 63, wid = __builtin_amdgcn_readfirstlane(tid >> 6);
    const int a_ = u & 127, i_ = u >> 7, j_ = a_ >> 5, bh = a_ & 31;
    const int qb = (i_ == 0) ? 15 - j_ : ((i_ == 1) ? j_ : ((i_ == 2) ? 11 - j_ : 4 + j_)), b = bh >> 3, h = bh & 7, q0 = qb * 128;
    const int g = lane >> 4, c16 = lane & 15;
    const float lam_init = 0.8f - 0.6f * expf(-0.3f * (float)l);
    float lam;
    { const float* lv = a_lambda + (size_t)l * 256; const float s1 = wave_sum(lv[lane] * lv[64 + lane]), s2 = wave_sum(lv[128 + lane] * lv[192 + lane]); lam = expf(s1) - expf(s2) + lam_init; }
    const int qrow = q0 + 16 * wid + c16;
    bf16x8 qf[2][2];
#pragma unroll
    for (int n = 0; n < 2; ++n)
#pragma unroll
        for (int ks = 0; ks < 2; ++ks) qf[n][ks] = *(const bf16x8*)(proj + ((size_t)b * SEQ + qrow) * NP + C_AQ + h * 128 + n * 64 + ks * 32 + g * 8);
    float mrow[2] = {-1e30f, -1e30f}, lrow[2] = {0.f, 0.f}; f32x4 O[2][8];
#pragma unroll
    for (int n = 0; n < 2; ++n)
#pragma unroll
        for (int e = 0; e < 8; ++e) O[n][e] = (f32x4){0.f, 0.f, 0.f, 0.f};
    const int ntiles = 2 * qb + 2;
    const int lr = tid >> 4, lc = (tid & 15) * 8;
    const bf16_t* pk = proj + ((size_t)b * SEQ + lr) * NP + C_AK + h * 128 + lc;
    const bf16_t* pvv = proj + ((size_t)b * SEQ + lr) * NP + C_AV + h * 128 + lc;
    u32x4 rk0 = *(const u32x4*)pk, rk1 = *(const u32x4*)(pk + (size_t)32 * NP), rv0 = *(const u32x4*)pvv, rv1 = *(const u32x4*)(pvv + (size_t)32 * NP);
    __syncthreads();
    for (int jt = 0; jt < ntiles; ++jt) {
        LAS bf16_t* KS = (LAS bf16_t*)(lds + (jt & 1) * 17408);
        LAS bf16_t* VS = (LAS bf16_t*)(lds + 34816 + (jt & 1) * 18432);
        *(LAS u32x4*)(KS + lr * 136 + lc) = rk0; *(LAS u32x4*)(KS + (lr + 32) * 136 + lc) = rk1;
        *(LAS u32x4*)(VS + lr * 144 + lc) = rv0; *(LAS u32x4*)(VS + (lr + 32) * 144 + lc) = rv1;
        __syncthreads();
        if (jt + 1 < ntiles) { pk += (size_t)64 * NP; pvv += (size_t)64 * NP;
            rk0 = *(const u32x4*)pk; rk1 = *(const u32x4*)(pk + (size_t)32 * NP); rv0 = *(const u32x4*)pvv; rv1 = *(const u32x4*)(pvv + (size_t)32 * NP); }
        const bool need_mask = (jt * 64 + 63 > q0 + 16 * wid);
        union { bf16x8 v; unsigned w[4]; } pb[2][2];
#pragma unroll
        for (int n = 0; n < 2; ++n) {
            f32x4 s[4];
#pragma unroll
            for (int it = 0; it < 4; ++it) {
                s[it] = (f32x4){0.f, 0.f, 0.f, 0.f};
#pragma unroll
                for (int ks = 0; ks < 2; ++ks) s[it] = MFMA16(*(const LAS bf16x8*)(KS + (it * 16 + c16) * 136 + n * 64 + ks * 32 + g * 8), qf[n][ks], s[it]);
            }
            if (need_mask) {
#pragma unroll
                for (int it = 0; it < 4; ++it)
#pragma unroll
                    for (int r = 0; r < 4; ++r) { const int key = jt * 64 + 16 * it + 4 * g + r; if (key > qrow) s[it][r] = -1e30f; }
            }
            float mx = -1e30f;
#pragma unroll
            for (int it = 0; it < 4; ++it) mx = fmaxf(mx, fmaxf(fmaxf(s[it][0], s[it][1]), fmaxf(s[it][2], s[it][3])));
            mx = fmaxf(mx, __shfl_xor(mx, 16)); mx = fmaxf(mx, __shfl_xor(mx, 32));
            const float mnew = (mx > mrow[n] + 8.0f) ? mx : mrow[n];
            float ps = 0.f;
#pragma unroll
            for (int it = 0; it < 4; ++it)
#pragma unroll
                for (int r = 0; r < 4; ++r) { s[it][r] = __builtin_amdgcn_exp2f(s[it][r] - mnew); ps += s[it][r]; }
            ps += __shfl_xor(ps, 16); ps += __shfl_xor(ps, 32);
            if (__builtin_amdgcn_ballot_w64(mnew != mrow[n]) != 0ull) {
                const float alpha = __builtin_amdgcn_exp2f(mrow[n] - mnew);
                lrow[n] = lrow[n] * alpha;
#pragma unroll
                for (int e = 0; e < 8; ++e) O[n][e] = O[n][e] * alpha;
            }
            lrow[n] += ps; mrow[n] = mnew;
#pragma unroll
            for (int ks = 0; ks < 2; ++ks) {
                pb[n][ks].w[0] = pk2(s[2 * ks][0], s[2 * ks][1]); pb[n][ks].w[1] = pk2(s[2 * ks][2], s[2 * ks][3]);
                pb[n][ks].w[2] = pk2(s[2 * ks + 1][0], s[2 * ks + 1][1]); pb[n][ks].w[3] = pk2(s[2 * ks + 1][2], s[2 * ks + 1][3]);
            }
        }
#pragma unroll
        for (int ks = 0; ks < 2; ++ks) {
            const LAS bf16_t* vb = VS + (32 * ks + 4 * g + (c16 >> 2)) * 144 + 4 * (c16 & 3);
#pragma unroll
            for (int e = 0; e < 8; ++e) {
                const bf16x8 vf = trfrag2(vb + 16 * e, vb + 16 * 144 + 16 * e);
                O[0][e] = MFMA16(vf, pb[0][ks].v, O[0][e]); O[1][e] = MFMA16(vf, pb[1][ks].v, O[1][e]);
            }
        }
    }
    {
        const float i0 = 1.0f / lrow[0], i1 = lam / lrow[1]; float ss = 0.f;
#pragma unroll
        for (int e = 0; e < 8; ++e) { O[0][e] = O[0][e] * i0 - O[1][e] * i1; ss += (O[0][e][0] * O[0][e][0] + O[0][e][1] * O[0][e][1]) + (O[0][e][2] * O[0][e][2] + O[0][e][3] * O[0][e][3]); }
        ss += __shfl_xor(ss, 16); ss += __shfl_xor(ss, 32);
        const float rsn = 1.0f / sqrtf(ss * (1.0f / 128.0f) + NORM_EPS) * (1.0f - lam_init);
        bf16_t* orow = ha + ((size_t)b * SEQ + qrow) * 1024 + h * 128 + 4 * g;
        const float* nw = a_norm_w + l * 1024 + h * 128 + 4 * g;
#pragma unroll
        for (int e = 0; e < 8; ++e) {
            const f32x4 wv = *(const f32x4*)(nw + 16 * e);
            u32x2 w; w.x = pk2(O[0][e][0] * rsn * wv[0], O[0][e][1] * rsn * wv[1]); w.y = pk2(O[0][e][2] * rsn * wv[2], O[0][e][3] * rsn * wv[3]);
            *(u32x2*)(orow + 16 * e) = w;
        }
    }
}


#define XB_TMO      128
#define XB_XCNT(j)  (256  + 64 * (j))
#define XB_XSUB(j)  (1280 + 64 * (j))
#define XB_XGEN(j)  (2304 + 64 * (j))
#define XB_TOP      3328
#define XB_TOPGEN   3392
#define XCD_BAR_WORDS 3456
#define XB_SPIN_CAP (1u << 18)
__device__ __forceinline__ unsigned xb_ld(unsigned* p)              { return __hip_atomic_load(p, __ATOMIC_RELAXED, __HIP_MEMORY_SCOPE_AGENT); }
__device__ __forceinline__ unsigned xb_add(unsigned* p, unsigned v) { return __hip_atomic_fetch_add(p, v, __ATOMIC_RELAXED, __HIP_MEMORY_SCOPE_AGENT); }
__device__ __forceinline__ unsigned xb_xcc_id() { return (unsigned)__builtin_amdgcn_s_getreg((3 << 11) | 20) & 0xFu; }
#define XB_SPIN(cond, bar) do { unsigned _sp = 0; while (cond) { \
    if ((++_sp & 255u) == 0u) { if (xb_ld(&(bar)[XB_TMO])) break; if (_sp > XB_SPIN_CAP) { atomicAdd(&(bar)[XB_TMO], 1u); break; } } } } while (0)
struct XcdBarrier { unsigned* bar; unsigned x; volatile LAS unsigned* st; };
__device__ __forceinline__ XcdBarrier xcd_barrier_post(unsigned* bar, volatile LAS unsigned* st) {
    XcdBarrier b; b.bar = bar; b.x = xb_xcc_id(); b.st = st;
    if (threadIdx.x == 0) (void)xb_add(&bar[XB_XCNT(b.x)], 1u);
    return b;
}
__device__ __forceinline__ void xcd_barrier_complete(unsigned* bar, unsigned x, unsigned& nloc, unsigned& nx) {
    const unsigned G = gridDim.x * gridDim.y * gridDim.z;
    unsigned sum, cnt, mine, sp = 0u;
    for (;;) {
        sum = 0u; cnt = 0u; mine = 0u;
#pragma unroll
        for (unsigned j = 0; j < 16; ++j) { const unsigned c = xb_ld(&bar[XB_XCNT(j)]); sum += c; cnt += (c > 0u) ? 1u : 0u; mine = (j == x) ? c : mine; }
        if (sum == G) break;
        __builtin_amdgcn_s_sleep(1);
        if ((++sp & 255u) == 0u) { if (xb_ld(&bar[XB_TMO])) break; if (sp > XB_SPIN_CAP) { atomicAdd(&bar[XB_TMO], 1u); break; } }
    }
    nloc = mine > 0u ? mine : 1u; nx = cnt > 0u ? cnt : 1u;
}
__device__ __forceinline__ void xcd_barrier(const XcdBarrier& b) {
    asm volatile("s_waitcnt vmcnt(0)" ::: "memory");
    __syncthreads();
    if (threadIdx.x == 0) {
        unsigned* bar = b.bar;
        __builtin_amdgcn_s_waitcnt(0);
        unsigned nloc = b.st[0], nx = b.st[1];
        if (nloc == 0u) { xcd_barrier_complete(bar, b.x, nloc, nx); b.st[0] = nloc; b.st[1] = nx; }
        const unsigned old = xb_add(&bar[XB_XSUB(b.x)], 1u);
        const unsigned gen = old / nloc;
        if (old + 1u == (gen + 1u) * nloc) {
            __builtin_amdgcn_fence(__ATOMIC_RELEASE, "agent");
            asm volatile("s_waitcnt vmcnt(0)" ::: "memory");
            const unsigned og = xb_add(&bar[XB_TOP], 1u);
            const unsigned tg = og / nx;
            if (og + 1u == (tg + 1u) * nx) xb_add(&bar[XB_TOPGEN], 1u);
            else XB_SPIN(xb_ld(&bar[XB_TOPGEN]) == tg, bar);
            __builtin_amdgcn_fence(__ATOMIC_ACQUIRE, "agent");
            xb_add(&bar[XB_XGEN(b.x)], 1u);
            asm volatile("s_waitcnt vmcnt(0)" ::: "memory");
        } else {
            XB_SPIN(xb_ld(&bar[XB_XGEN(b.x)]) == gen, bar);
            __builtin_amdgcn_fence(__ATOMIC_ACQUIRE, "agent");
            asm volatile("s_waitcnt vmcnt(0)" ::: "memory");
        }
    }
    __syncthreads();
}

__global__ void __launch_bounds__(NTHREADS, 2) fwd_megakernel(Params P) {
    extern __shared__ __attribute__((aligned(16))) unsigned char lds_raw[];
    LAS unsigned char* lds = (LAS unsigned char*)lds_raw;
    cg::grid_group grid = cg::this_grid();
    volatile LAS unsigned* bst = (volatile LAS unsigned*)(lds + LDS_BYTES - 16);
    if (threadIdx.x == 0) { bst[0] = 0u; bst[1] = 0u; }
    __syncthreads();
    const XcdBarrier xbar = xcd_barrier_post((unsigned*)(KWS + WS_BAR), bst);
    const int G = gridDim.x, bid = blockIdx.x;
#define positions ((const int*)KIN(1))
#define w_in KIN(4)
#define conv_w KIN(5)
#define conv_b KIN(6)
#define gate_b KIN(7)
#define m_norm_w KIN(8)
#define a_lambda KIN(9)
#define a_norm_w KIN(10)
#define lb_logits KIN(11)
#define g_norm_w KIN(12)
#define B_Hf ((float*)(KWS + WS_H))
#define B_Hb ((bf16_t*)(KWS + WS_HB))
#define B_PROJ ((bf16_t*)(KWS + WS_PROJ))
#define B_ACT B_PROJ
#define B_HCAT ((bf16_t*)(KWS + WS_HCAT))
#define B_MPART ((bf16_t*)(KWS + WS_MPART))
#define B_DPART ((float*)(KWS + WS_DPART))
#define B_HPART ((bf16_t*)(KWS + WS_HPART))
#define B_YF ((float*)(KWS + WS_YF))
#define B_YB ((bf16_t*)(KWS + WS_YB))
#define B_TF ((float*)(KWS + WS_TF))
#define B_GIF ((float*)(KWS + WS_GPART))
#define B_ROPE ((float*)(KWS + WS_ROPE))
    {
        const int tid = launder_i(threadIdx.x), lane = tid & 63, wid = tid >> 6;
        LAS float* scr = (LAS float*)(lds + wid * 16640);
        const int gw = bid * NWAVES + wid, NGW = G * NWAVES;
        constexpr int I_IN = (D / 64) * (NP / 64), I_P = (1024 / 64) * (D / 64), I_O = (D / 64) * (D / 64), I_U = (D / 64) * (FF / 64), I_D = (FF / 64) * (D / 64);
        constexpr int I_L = I_IN + 3 * I_P + I_O + I_U + I_D;
        const float* q_win = KIN(4); const float* q_pm = KIN(13); const float* q_pa = KIN(14); const float* q_pg = KIN(15); const float* q_wo = KIN(16); const float* q_up = KIN(19); const float* q_dn = KIN(20);
        unsigned char* q_ws = KWS; const int* q_pos = (const int*)KIN(1);
        for (int rp0 = 0; rp0 < REP_P0; ++rp0)
        for (int it = gw; it < DEPTH * I_L; it += NGW) {
            const int l = it / I_L; int r = it % I_L;
            if (r < I_IN) { tr_matrix_item(q_win + (size_t)l * D * NSRC, D, NP, NSRC, true, (bf16_t*)(q_ws + WS_WIN + l * SZ_WIN), r, scr, lane); continue; } r -= I_IN;
            if (r < I_P) { tr_matrix_item(q_pm + (size_t)l * 1024 * D, 1024, D, D, false, (bf16_t*)(q_ws + WS_WPM + l * SZ_WP), r, scr, lane); continue; } r -= I_P;
            if (r < I_P) { tr_matrix_item(q_pa + (size_t)l * 1024 * D, 1024, D, D, false, (bf16_t*)(q_ws + WS_WPA + l * SZ_WP), r, scr, lane); continue; } r -= I_P;
            if (r < I_P) { tr_matrix_item(q_pg + (size_t)l * 1024 * D, 1024, D, D, false, (bf16_t*)(q_ws + WS_WPG + l * SZ_WP), r, scr, lane); continue; } r -= I_P;
            if (r < I_O) { tr_matrix_item(q_wo + (size_t)l * D * D, D, D, D, false, (bf16_t*)(q_ws + WS_WOUT + l * SZ_WOUT), r, scr, lane); continue; } r -= I_O;
            if (r < I_U) { tr_matrix_item(q_up + (size_t)l * D * FF, D, FF, FF, false, (bf16_t*)(q_ws + WS_WUP + l * SZ_WUP), r, scr, lane); continue; } r -= I_U;
            tr_matrix_item(q_dn + (size_t)l * FF * D, FF, D, D, false, (bf16_t*)(q_ws + WS_WDN + l * SZ_WDN), r, scr, lane);
        }
        for (int i = bid * NTHREADS + tid; i < T * 8; i += G * NTHREADS) {
            const int row = i >> 3, f = i & 7;
            const float inv = powf(500000.0f, -(float)(2 * f) / 16.0f);
            const float ang = (float)q_pos[row] * inv;
            float* q_rope = (float*)(q_ws + WS_ROPE); q_rope[row * 16 + f] = cosf(ang); q_rope[row * 16 + 8 + f] = sinf(ang);
        }
        __syncthreads();
        ln_phase<true, true, false, false>(KIN(0), KIN(2), KIN(3), nullptr, B_Hb, w_in, gate_b, B_GIF, lds, G);
    }
    xcd_barrier(xbar);
    if (G == 0x40000000) grid.sync();

#pragma unroll 1
    for (int l = 0; l < DEPTH; ++l) {
        {
            pg8::Sched S; S.init(T, 16384, D, 1, G, bid);
            S.strideA = S.strideB = 0; S.A0 = (const char*)B_Hb; S.B0 = (const char*)(KWS + WS_WIN + l * SZ_WIN);
            pg8::EpiProj E; E.O = B_PROJ; E.rope = B_ROPE; E.pn_off = 0;
#if !defined(SKIP_GEMM) && !defined(SKIP_G0)
            for (int rep = 0; rep < REP_GEMM; ++rep) pg8::gemm_phase(lds, S, E);
#endif
        }
        xcd_barrier(xbar);
        {
            const int gm = G / 4, gh = G / 4, ga = G - gm - gh;
            if (bid < gm) { for (int rep = 0; rep < REP_M; ++rep) for (int u = bid; u < 64; u += gm) {
#ifndef SKIP_MLSTM
 mlstm_unit(u, l, B_PROJ, B_GIF, conv_w, conv_b, B_MPART + (size_t)(u & 3) * T * 1024, B_DPART + (size_t)(u & 3) * T * 4, (l > 0 && G == 256) ? 8 : 1, lds);
#endif
 } }
            else if (bid < gm + gh) { for (int rep = 0; rep < REP_H; ++rep) for (int u = bid - gm; u < 64; u += gh) {
#ifndef SKIP_HGRN
 hgrn_unit(u, l, B_PROJ, lb_logits, B_HPART + (size_t)(u & 1) * T * 1024, lds);
#endif
 } }
            else { for (int rep = 0; rep < REP_A; ++rep) for (int u = bid - gm - gh; u < 512; u += ga) {
#ifndef SKIP_ATTN
 attn_unit(u, l, B_PROJ, a_lambda, a_norm_w, B_HCAT + (size_t)T * 1024, lds);
#endif
 }
                {
                    __syncthreads();
                    pg8::Sched S; S.init(T, 1024, D, 1, ga, bid - gm - gh);
                    S.strideA = S.strideB = 0; S.A0 = (const char*)B_Hb; S.B0 = (const char*)(KWS + WS_WIN + l * SZ_WIN + (size_t)16384 * D * 2);
                    pg8::EpiProj E; E.O = B_PROJ; E.rope = B_ROPE; E.pn_off = 64;
                    pg8::gemm_phase(lds, S, E);
                }
            }
        }
        xcd_barrier(xbar);
        { const int tid = launder_i(threadIdx.x), lane = tid & 63, wid = tid >> 6;
        const bf16_t* q_mp = B_MPART; const float* q_dp = B_DPART; const bf16_t* q_hp = B_HPART; const float* q_mnw = m_norm_w; const float* q_gnw = g_norm_w; const bf16_t* q_proj = B_PROJ; bf16_t* q_hcat = B_HCAT;
        const int step = G * NWAVES;
        for (int it0 = bid * NWAVES + wid; it0 < T * 4; it0 += 2 * step) {
            f32x4 v[2]; float den[2]; u32x2 mo[2]; bool ok[2];
#pragma unroll
            for (int q = 0; q < 2; ++q) {
                const int it = it0 + q * step; ok[q] = it < T * 4; const int itc = ok[q] ? it : it0;
                const int row = itc >> 2, h = itc & 3; const size_t o = (size_t)row * 1024 + h * 256 + 4 * lane;
                v[q] = (f32x4){0.f, 0.f, 0.f, 0.f}; den[q] = 0.f;
#pragma unroll
                for (int dq = 0; dq < 4; ++dq) { const u32x2 p = *(const u32x2*)(q_mp + (size_t)dq * T * 1024 + o);
                    v[q][0] += bflo(p.x); v[q][1] += bfhi(p.x); v[q][2] += bflo(p.y); v[q][3] += bfhi(p.y); den[q] += q_dp[(size_t)dq * T * 4 + (size_t)row * 4 + h]; }
                mo[q] = *(const u32x2*)(q_proj + (size_t)row * NP + C_MO + h * 256 + 4 * lane);
            }
#pragma unroll
            for (int q = 0; q < 2; ++q) {
                const int it = it0 + q * step; const int itc = ok[q] ? it : it0; const int row = itc >> 2, h = itc & 3;
                const f32x4 x = v[q] * (1.0f / fmaxf(fabsf(den[q]), 1.0f));
                const float ss = wave_sum((x[0] * x[0] + x[1] * x[1]) + (x[2] * x[2] + x[3] * x[3]));
                const float rsn = 1.0f / sqrtf(ss * (1.0f / 256.0f) + NORM_EPS);
                const f32x4 wn = *(const f32x4*)(q_mnw + l * 1024 + h * 256 + 4 * lane);
                u32x2 ow;
                ow.x = pk2(x[0] * rsn * wn[0] * sigmoidf_(bflo(mo[q].x)), x[1] * rsn * wn[1] * sigmoidf_(bfhi(mo[q].x)));
                ow.y = pk2(x[2] * rsn * wn[2] * sigmoidf_(bflo(mo[q].y)), x[3] * rsn * wn[3] * sigmoidf_(bfhi(mo[q].y)));
                if (ok[q]) *(u32x2*)(q_hcat + (size_t)row * 1024 + h * 256 + 4 * lane) = ow;
            }
        }
        for (int it0 = bid * NWAVES + wid; it0 < T * 4; it0 += 2 * step) {
            f32x4 v[2]; u32x2 gg[2]; bool ok[2];
#pragma unroll
            for (int q = 0; q < 2; ++q) {
                const int it = it0 + q * step; ok[q] = it < T * 4; const int itc = ok[q] ? it : it0;
                const int row = itc >> 2, hp = itc & 3; const size_t o = (size_t)row * 1024 + hp * 256 + 4 * lane;
                const u32x2 p0 = *(const u32x2*)(q_hp + o), p1 = *(const u32x2*)(q_hp + (size_t)T * 1024 + o);
                v[q][0] = bflo(p0.x) + bflo(p1.x); v[q][1] = bfhi(p0.x) + bfhi(p1.x); v[q][2] = bflo(p0.y) + bflo(p1.y); v[q][3] = bfhi(p0.y) + bfhi(p1.y);
                gg[q] = *(const u32x2*)(q_proj + (size_t)row * NP + C_GG + hp * 256 + 4 * lane);
            }
#pragma unroll
            for (int q = 0; q < 2; ++q) {
                const int it = it0 + q * step; const int itc = ok[q] ? it : it0; const int row = itc >> 2, hp = itc & 3; const size_t o = (size_t)row * 1024 + hp * 256 + 4 * lane;
                const f32x4 x = v[q];
                float ss = (x[0] * x[0] + x[1] * x[1]) + (x[2] * x[2] + x[3] * x[3]);
#pragma unroll
                for (int off = 1; off < 32; off <<= 1) ss += __shfl_xor(ss, off);
                const float rsn = 1.0f / sqrtf(ss * (1.0f / 128.0f) + NORM_EPS);
                const f32x4 wn = *(const f32x4*)(q_gnw + l * 1024 + hp * 256 + 4 * lane);
                u32x2 ow;
                ow.x = pk2(x[0] * rsn * wn[0] * siluf_(bflo(gg[q].x)), x[1] * rsn * wn[1] * siluf_(bfhi(gg[q].x)));
                ow.y = pk2(x[2] * rsn * wn[2] * siluf_(bflo(gg[q].y)), x[3] * rsn * wn[3] * siluf_(bfhi(gg[q].y)));
                if (ok[q]) *(u32x2*)(q_hcat + (size_t)2 * T * 1024 + o) = ow;
            }
        } }
        xcd_barrier(xbar);
        {
            pg8::Sched S; S.init(T, D, 1024, 3, G, bid);
            S.A0 = (const char*)B_HCAT; S.strideA = T * 1024 * 2;
            S.B0 = (const char*)(KWS + WS_WPM + l * SZ_WP); S.strideB = (int)(DEPTH * SZ_WP);
            pg8::EpiMerge E; E.proj = B_PROJ; E.YB = B_YB;
#if !defined(SKIP_GEMM) && !defined(SKIP_G1)
            for (int rep = 0; rep < REP_GEMM; ++rep) pg8::gemm_phase(lds, S, E);
#endif
        }
        xcd_barrier(xbar);
        {
            pg8::Sched S; S.init(T, D, D, 1, G, bid);
            S.strideA = S.strideB = 0; S.A0 = (const char*)B_YB; S.B0 = (const char*)(KWS + WS_WOUT + l * SZ_WOUT);
            if (G == 256) {
                pg8::EpiLn<false, false> E; E.H = B_Hb; E.w = KIN(17) + l * D; E.b = KIN(18) + l * D; E.outB = B_Hb; E.outF = nullptr; E.win_next = nullptr; E.gbias = nullptr; E.gpart = nullptr;
                E.st.xbuf = (unsigned long long*)(KWS + WS_XBUF) + (size_t)l * T * 8; E.st.cnt = (unsigned*)(KWS + WS_CNT) + l * 32 * 64; E.st.eps = LN_EPS;
                pg8::gemm_phase(lds, S, E);
            } else {
                pg8::EpiResid E; E.H = B_Hb; E.TF = (bf16_t*)B_TF;
                pg8::gemm_phase(lds, S, E);
            }
        }
        xcd_barrier(xbar);
        if (G != 256) {
            ln_phase<false, true, false, true>(B_TF, KIN(17) + l * D, KIN(18) + l * D, nullptr, B_Hb, nullptr, nullptr, nullptr, lds, G);
            xcd_barrier(xbar);
        }
        {
            pg8::Sched S; S.init(T, FF, D, 1, G, bid);
            S.strideA = S.strideB = 0; S.A0 = (const char*)B_Hb; S.B0 = (const char*)(KWS + WS_WUP + l * SZ_WUP);
            pg8::EpiRelu2 E; E.O = B_ACT;
#if !defined(SKIP_GEMM) && !defined(SKIP_G3)
            for (int rep = 0; rep < REP_GEMM; ++rep) pg8::gemm_phase(lds, S, E);
#endif
        }
        xcd_barrier(xbar);
        {
            pg8::Sched S; S.init(T, D, FF, 1, G, bid);
            S.strideA = S.strideB = 0; S.A0 = (const char*)B_ACT; S.B0 = (const char*)(KWS + WS_WDN + l * SZ_WDN);
            if (G == 256 && l + 1 == DEPTH) {
                pg8::EpiLn<true, false> E; E.H = B_Hb; E.w = KIN(21) + l * D; E.b = KIN(22) + l * D; E.outB = nullptr; E.outF = kparams()->out; E.win_next = nullptr; E.gbias = nullptr; E.gpart = nullptr;
                E.st.xbuf = (unsigned long long*)(KWS + WS_XBUF) + (size_t)DEPTH * T * 8; E.st.cnt = (unsigned*)(KWS + WS_CNT) + DEPTH * 32 * 64; E.st.eps = LN_EPS;
                pg8::gemm_phase(lds, S, E);
            } else if (G == 256) {
                pg8::EpiLn<false, true> E; E.H = B_Hb; E.w = KIN(21) + l * D; E.b = KIN(22) + l * D; E.outB = B_Hb; E.outF = nullptr;
                E.win_next = w_in + (size_t)(l + 1) * D * NSRC; E.gbias = gate_b + (l + 1) * 8; E.gpart = B_GIF;
                E.st.xbuf = (unsigned long long*)(KWS + WS_XBUF) + (size_t)(DEPTH + 1 + l) * T * 8; E.st.cnt = (unsigned*)(KWS + WS_CNT) + (DEPTH + 1 + l) * 32 * 64; E.st.eps = LN_EPS;
                pg8::gemm_phase(lds, S, E);
            } else {
                pg8::EpiResid E; E.H = B_Hb; E.TF = (bf16_t*)B_TF;
                pg8::gemm_phase(lds, S, E);
            }
        }
        if (G == 256 && l + 1 == DEPTH) break;
        xcd_barrier(xbar);
        if (G == 256) continue;
        if (l + 1 < DEPTH) {
            ln_phase<true, true, false, true>(B_TF, KIN(21) + l * D, KIN(22) + l * D, nullptr, B_Hb, w_in + (size_t)(l + 1) * D * NSRC, gate_b + (l + 1) * 8, B_GIF, lds, G);
            xcd_barrier(xbar);
        } else {
            ln_phase<false, false, true, true>(B_TF, KIN(21) + l * D, KIN(22) + l * D, kparams()->out, nullptr, nullptr, nullptr, nullptr, lds, G);
        }
    }
}

extern "C" void kernel_launch(void* const* d_in, const int* in_sizes, int n_in, void* d_out, int out_size, void* d_ws, size_t ws_size, hipStream_t stream) {
    static int grid_blocks = 0;
    if (grid_blocks == 0) {
        if (n_in != 23 || out_size != T * D || ws_size < WS_END) { fprintf(stderr, "kernel_launch: unexpected shapes (n_in %d out %d ws %zu need %zu)\n", n_in, out_size, ws_size, (size_t)WS_END); grid_blocks = -1; return; }
        int dev = 0, cus = 0, per_cu = 0;
        hipGetDevice(&dev);
        hipDeviceGetAttribute(&cus, hipDeviceAttributeMultiprocessorCount, dev);
        if (hipFuncSetAttribute((const void*)fwd_megakernel, hipFuncAttributeMaxDynamicSharedMemorySize, LDS_BYTES) != hipSuccess) { fprintf(stderr, "kernel_launch: hipFuncSetAttribute failed\n"); grid_blocks = -1; return; }
        hipOccupancyMaxActiveBlocksPerMultiprocessor(&per_cu, (const void*)fwd_megakernel, NTHREADS, LDS_BYTES);
        if (per_cu < 1) { fprintf(stderr, "kernel_launch: occupancy query says %d blocks per CU\n", per_cu); per_cu = 1; }
        (void)hipGetLastError();
        grid_blocks = cus * 1;
    }
    if (grid_blocks < 0) return;
    if (hipMemsetAsync((char*)d_ws + WS_BAR, 0, WS_ZERO_BYTES, stream) != hipSuccess) { fprintf(stderr, "kernel_launch: memset failed\n"); return; }
    Params p{};
    for (int i = 0; i < 23; ++i) p.in[i] = (const float*)d_in[i];
    p.out = (float*)d_out; p.wsp = (unsigned char*)d_ws;
    void* args[] = {&p};
    hipError_t e = hipLaunchCooperativeKernel((const void*)fwd_megakernel, dim3(grid_blocks), dim3(NTHREADS), args, LDS_BYTES, stream);
    if (e != hipSuccess) fprintf(stderr, "cooperative launch failed: %s (grid %d)\n", hipGetErrorString(e), grid_blocks);
}
```

```cpp
#include <hip/hip_runtime.h>
#include <hip/hip_cooperative_groups.h>
#include <cstdio>
#include <cstdint>
namespace cg = cooperative_groups;

#define LAS __attribute__((address_space(3)))
typedef unsigned short bf16_t;
typedef short bf16x8 __attribute__((ext_vector_type(8)));
typedef float f32x4 __attribute__((ext_vector_type(4)));
typedef unsigned u32x4 __attribute__((ext_vector_type(4)));
typedef unsigned u32x2 __attribute__((ext_vector_type(2)));

constexpr int T = 8192, SEQ = 2048, D = 2048, NP = 17408, NSRC = 17416, FF = 8192, DEPTH = 2;
constexpr int C_MQ = 0, C_MK = 1024, C_MV = 2048, C_MO = 3072, C_AQ = 4096, C_AK = 5120, C_AV = 6144, C_GQ = 7168, C_GF = 8192, C_GI = 9216, C_GG = 10240, C_GATE = 11264;
constexpr float ALPHA = 1.41421356237f;
constexpr float LN_EPS = 1e-5f, NORM_EPS = 1e-6f;
constexpr int NTHREADS = 512, NWAVES = 8;
constexpr int LDS_BYTES = 159744;
#ifndef REP_P0
#define REP_P0 1
#endif
#ifndef REP_GEMM
#define REP_GEMM 1
#endif
#ifndef REP_M
#define REP_M 1
#endif
#ifndef REP_H
#define REP_H 1
#endif
#ifndef REP_A
#define REP_A 1
#endif

constexpr size_t SZ_WIN = (size_t)NP * D * 2, SZ_WP = (size_t)2048 * 1024 * 2, SZ_WOUT = (size_t)D * D * 2, SZ_WUP = (size_t)FF * D * 2, SZ_WDN = (size_t)D * FF * 2;
constexpr size_t WS_WIN = 0;
constexpr size_t WS_WPM = WS_WIN + DEPTH * SZ_WIN;
constexpr size_t WS_WPA = WS_WPM + DEPTH * SZ_WP;
constexpr size_t WS_WPG = WS_WPA + DEPTH * SZ_WP;
constexpr size_t WS_WOUT = WS_WPG + DEPTH * SZ_WP;
constexpr size_t WS_WUP = WS_WOUT + DEPTH * SZ_WOUT;
constexpr size_t WS_WDN = WS_WUP + DEPTH * SZ_WUP;
constexpr size_t WS_H = WS_WDN + DEPTH * SZ_WDN;
constexpr size_t WS_HB = WS_H + (size_t)T * D * 4;
constexpr size_t WS_PROJ = WS_HB + (size_t)T * D * 2;
constexpr size_t WS_HCAT = WS_PROJ + (size_t)T * NP * 2;
constexpr size_t WS_HPART = WS_HCAT + (size_t)3 * T * 1024 * 2;
constexpr size_t WS_YF = WS_HPART + (size_t)2 * T * 1024 * 4;
constexpr size_t WS_YB = WS_YF + (size_t)T * D * 4;
constexpr size_t WS_TF = WS_YB + (size_t)T * D * 2;
constexpr size_t WS_MPART = WS_YF;
constexpr size_t WS_GIF = WS_TF + (size_t)T * D * 4;
constexpr size_t WS_ROPE = WS_GIF + (size_t)T * 8 * 4;
constexpr size_t WS_DPART = WS_ROPE + (size_t)T * 16 * 4;
constexpr size_t WS_BAR = WS_DPART + (size_t)4 * T * 4 * 4;
static_assert((size_t)4 * T * 1024 * 4 <= (size_t)T * D * 4 + (size_t)T * D * 2 + (size_t)T * D * 4, "MPART fits in YF | YB | TF");
constexpr size_t WS_CNT = WS_BAR + 16384;
constexpr size_t WS_ZERO_BYTES = 16384 + 4 * 32 * 256;
constexpr size_t WS_XBUF = WS_CNT + 4 * 32 * 256;
constexpr size_t WS_GPART = WS_XBUF + (size_t)4 * T * 8 * 8;
constexpr size_t WS_END = WS_GPART + (size_t)8 * T * 8 * 4;

struct Params { const float* in[23]; float* out; unsigned char* wsp; };
typedef const __attribute__((address_space(4))) Params* KP;
__device__ __forceinline__ KP kparams() { KP p = (KP)__builtin_amdgcn_kernarg_segment_ptr(); asm volatile("" : "+s"(p)); return p; }
#define KIN(i) (kparams()->in[i])
#define KWS (kparams()->wsp)

__device__ __forceinline__ unsigned pk2(float lo, float hi);
__device__ __forceinline__ unsigned f2bf(float f) { return pk2(f, 0.f) & 0xffffu; }
typedef float f32x2_t __attribute__((ext_vector_type(2)));
typedef __bf16 bf16x2_t __attribute__((ext_vector_type(2)));
__device__ __forceinline__ unsigned pk2(float lo, float hi) { f32x2_t v = {lo, hi}; bf16x2_t b = __builtin_convertvector(v, bf16x2_t); return __builtin_bit_cast(unsigned, b); }
__device__ __forceinline__ float bf2f(unsigned short b) { return __builtin_bit_cast(float, (unsigned)b << 16); }
__device__ __forceinline__ float bflo(unsigned w) { return __builtin_bit_cast(float, w << 16); }
__device__ __forceinline__ float bfhi(unsigned w) { return __builtin_bit_cast(float, w & 0xffff0000u); }
__device__ __forceinline__ float sigmoidf_(float x) { return __builtin_amdgcn_rcpf(1.0f + __expf(-x)); }
__device__ __forceinline__ float siluf_(float x) { return x * __builtin_amdgcn_rcpf(1.0f + __expf(-x)); }
__device__ __forceinline__ float wave_sum(float v) {
#pragma unroll
    for (int o = 1; o < 64; o <<= 1) v += __shfl_xor(v, o);
    return v;
}
__device__ __forceinline__ float sum16(float v) { v += __shfl_xor(v, 1); v += __shfl_xor(v, 2); v += __shfl_xor(v, 4); v += __shfl_xor(v, 8); return v; }
__device__ __forceinline__ float max16(float v) { v = fmaxf(v, __shfl_xor(v, 1)); v = fmaxf(v, __shfl_xor(v, 2)); v = fmaxf(v, __shfl_xor(v, 4)); v = fmaxf(v, __shfl_xor(v, 8)); return v; }
__device__ __forceinline__ int launder_i(int x) { asm volatile("" : "+v"(x)); return x; }
#define LBAR() do { asm volatile("s_waitcnt lgkmcnt(0)" ::: "memory"); __builtin_amdgcn_s_barrier(); asm volatile("" ::: "memory"); } while (0)
#define LDS_WAIT() asm volatile("s_waitcnt lgkmcnt(0)" ::: "memory")
__device__ __forceinline__ void unpack8(u32x4 w, float (&f)[8]) {
    f[0] = bflo(w.x); f[1] = bfhi(w.x); f[2] = bflo(w.y); f[3] = bfhi(w.y); f[4] = bflo(w.z); f[5] = bfhi(w.z); f[6] = bflo(w.w); f[7] = bfhi(w.w);
}
__device__ __forceinline__ bf16x8 frag(const LAS bf16_t* base, int ld, int tile, int ks, int lane) {
    return *(const LAS bf16x8*)(base + (tile * 16 + (lane & 15)) * ld + ks * 32 + (lane >> 4) * 8);
}
#define MFMA16(a, b, c) __builtin_amdgcn_mfma_f32_16x16x32_bf16((a), (b), (c), 0, 0, 0)

namespace pg8 {
constexpr int BM = 256, BK = 64, HALF = 128, HTB = HALF * BK * 2, STAGE_BYTES = 8 * HTB, NXCD = 8, WGM = 8;
__device__ __forceinline__ int lds_byte(int r, int c) { const int st = (r >> 4) * 2 + (c >> 5), rr = r & 15, cc = c & 31, ob = rr * 64 + cc * 2; return st * 1024 + (ob ^ (((ob >> 9) & 1) << 5)); }
__device__ __forceinline__ void stage_rc(int b, int& R, int& C) { const int st = b / 1024, sb = b % 1024, swz = sb ^ (((sb >> 9) & 1) << 5); R = (st >> 1) * 16 + swz / 64; C = (st & 1) * 32 + (swz % 64) / 2; }

struct Unit { int pm, pn, z; };
struct Sched {
    const char* A0; const char* B0; int strideA, strideB;
    int nM, nN, nwg, G, c, nz, K;
    __device__ __forceinline__ void init(int M, int N, int K_, int nz_, int G_, int c_) { nM = M / BM; nN = N / BM; nwg = nM * nN; G = G_; c = c_; nz = nz_; K = K_; }
    __device__ __forceinline__ bool next(int i, Unit& u) const {
        const int z = i % nz; const long L = (long)(i / nz) * G + c; if (L >= nwg) return false;
        int wgid = (int)L; { const int q = nwg / NXCD, r = nwg % NXCD, xcd = wgid % NXCD, off = wgid / NXCD; wgid = (xcd < r ? xcd * (q + 1) : r * (q + 1) + (xcd - r) * q) + off; }
        const int nig = WGM * nN, gid = wgid / nig, fm = gid * WGM, gsz = (nM - fm) < WGM ? (nM - fm) : WGM;
        u.pm = fm + ((wgid % nig) % gsz); u.pn = (wgid % nig) / gsz; u.z = z; return true;
    }
    __device__ __forceinline__ const char* abase(const Unit& u) const { return A0 + (size_t)u.z * strideA + (size_t)u.pm * (size_t)BM * K * 2; }
    __device__ __forceinline__ const char* bbase(const Unit& u) const { return B0 + (size_t)u.z * strideB + (size_t)u.pn * (size_t)BM * K * 2; }
};

template <class Epi>
__device__ __forceinline__ void gemm_phase(LAS unsigned char* lds, const Sched& S, const Epi& E) {
    const int tid = launder_i(threadIdx.x), wid = __builtin_amdgcn_readfirstlane(tid >> 6), lane = tid & 63, wr = wid >> 2, wc = wid & 3, fr = lane & 15, fq = lane >> 4;
    const int K = S.K, nt = K / BK;
    unsigned voffA[2], voffB[2];
#pragma unroll
    for (int i = 0; i < 2; ++i) { int R, C; stage_rc(tid * 16 + i * 8192, R, C); const int rho = R & 31, Rb = (R & ~31) + 8 * ((rho & 15) >> 2) + 4 * (rho >> 4) + (rho & 3);
        voffA[i] = (unsigned)(R * K + C) * 2u; voffB[i] = (unsigned)(Rb * K + C) * 2u; }
    const size_t kstep = (size_t)(BK * 2);
    const size_t hstep = (size_t)HALF * K * 2;
    const unsigned ldsw = (unsigned)wid * 1024u;
    const int aoff = lds_byte(wr * 64 + fr, fq * 8), boff = lds_byte(wc * 32 + fr, fq * 8);
#define PG8_SA(b, h) (((b) * 2 + (h)) * HTB)
#define PG8_SB(b, h) ((4 + (b) * 2 + (h)) * HTB)
#define PG8_STAGE2(bufoff, gbase, voff) do { _Pragma("unroll") for (int _i = 0; _i < 2; ++_i) \
        __builtin_amdgcn_global_load_lds((const unsigned*)((const char*)(gbase) + (voff)[_i]), (LAS unsigned*)(lds + (bufoff) + ldsw + _i * 8192), 16, 0, 0); } while (0)
#define PG8_LDA(dst, b, h) do { _Pragma("unroll") for (int m = 0; m < 4; ++m) _Pragma("unroll") for (int k = 0; k < 2; ++k) dst[m][k] = *(const LAS bf16x8*)(lds + PG8_SA(b, h) + aoff + m * 2048 + k * 1024); } while (0)
#define PG8_LDB(dst, b, h) do { _Pragma("unroll") for (int n = 0; n < 2; ++n) _Pragma("unroll") for (int k = 0; k < 2; ++k) dst[n][k] = *(const LAS bf16x8*)(lds + PG8_SB(b, h) + boff + n * 2048 + k * 1024); } while (0)
#define PG8_MMA(ai, bj, At, Bt) do { __builtin_amdgcn_s_setprio(1); _Pragma("unroll") for (int m = 0; m < 4; ++m) _Pragma("unroll") for (int n = 0; n < 2; ++n) _Pragma("unroll") for (int k = 0; k < 2; ++k) \
        acc[ai][bj][m][n] = __builtin_amdgcn_mfma_f32_16x16x32_bf16(Bt[n][k], At[m][k], acc[ai][bj][m][n], 0, 0, 0); __builtin_amdgcn_s_setprio(0); } while (0)
#define PG8_WAIT_V(n) asm volatile("s_waitcnt vmcnt(" #n ")" ::: "memory")
#define PG8_WAIT_L(n) asm volatile("s_waitcnt lgkmcnt(" #n ")" ::: "memory")
#define PG8_BAR __builtin_amdgcn_s_barrier()
#define PG8_SCHED __builtin_amdgcn_sched_barrier(0)
    Unit cur, nxt; int ui = 0;
    if (!S.next(0, cur)) return;
    f32x4 acc[2][2][4][2];
#pragma unroll
    for (int a = 0; a < 2; ++a)
#pragma unroll
        for (int b = 0; b < 2; ++b)
#pragma unroll
            for (int m = 0; m < 4; ++m)
#pragma unroll
                for (int n = 0; n < 2; ++n) acc[a][b][m][n] = (f32x4){0.f, 0.f, 0.f, 0.f};
    bf16x8 At[4][2], B0[2][2], B1[2][2];
    const char* cA = S.abase(cur); const char* cB = S.bbase(cur);
    PG8_STAGE2(PG8_SB(0, 0), cB, voffB); PG8_STAGE2(PG8_SB(0, 1), cB + hstep, voffB); PG8_STAGE2(PG8_SA(0, 0), cA, voffA); PG8_STAGE2(PG8_SA(0, 1), cA + hstep, voffA);
    if (wr == 1) PG8_BAR;
    PG8_WAIT_V(2); PG8_BAR;
    PG8_STAGE2(PG8_SB(1, 0), cB + kstep, voffB); PG8_STAGE2(PG8_SA(1, 0), cA + kstep, voffA); PG8_STAGE2(PG8_SB(1, 1), cB + hstep + kstep, voffB);
    PG8_WAIT_V(6); PG8_BAR;
    for (;;) {
        const bool has_next = S.next(ui + 1, nxt);
        const char* nA = has_next ? S.abase(nxt) : cA; const char* nB = has_next ? S.bbase(nxt) : cB;
        for (int t = 0; t < nt; t += 2) {
            const bool last = (t == nt - 2);
            const char* a1 = cA + (size_t)(t + 1) * kstep;
            const char* a2 = last ? nA : cA + (size_t)(t + 2) * kstep; const char* b2 = last ? nB : cB + (size_t)(t + 2) * kstep;
            const char* a3 = a2 + kstep; const char* b3 = b2 + kstep;
            PG8_LDB(B0, 0, 0); PG8_LDB(B1, 0, 1); PG8_SCHED; PG8_LDA(At, 0, 0); PG8_STAGE2(PG8_SA(1, 1), a1 + hstep, voffA);
            PG8_WAIT_V(8); PG8_WAIT_L(0); PG8_BAR; PG8_MMA(0, 0, At, B0); PG8_MMA(0, 1, At, B1); PG8_BAR; PG8_SCHED;
            PG8_LDA(At, 0, 1); PG8_STAGE2(PG8_SB(0, 0), b2, voffB); PG8_STAGE2(PG8_SB(0, 1), b2 + hstep, voffB); PG8_STAGE2(PG8_SA(0, 0), a2, voffA);
            PG8_WAIT_V(8); PG8_WAIT_L(0); PG8_BAR; PG8_MMA(1, 0, At, B0); PG8_MMA(1, 1, At, B1); PG8_BAR; PG8_SCHED;
            PG8_LDB(B0, 1, 0); PG8_LDB(B1, 1, 1); PG8_SCHED; PG8_LDA(At, 1, 0); PG8_STAGE2(PG8_SA(0, 1), a2 + hstep, voffA);
            PG8_WAIT_V(8); PG8_WAIT_L(0); PG8_BAR; PG8_MMA(0, 0, At, B0); PG8_MMA(0, 1, At, B1); PG8_BAR; PG8_SCHED;
            PG8_LDA(At, 1, 1); PG8_STAGE2(PG8_SB(1, 0), b3, voffB); PG8_STAGE2(PG8_SB(1, 1), b3 + hstep, voffB); PG8_STAGE2(PG8_SA(1, 0), a3, voffA);
            PG8_WAIT_V(8); PG8_WAIT_L(0); PG8_BAR; PG8_MMA(1, 0, At, B0); PG8_MMA(1, 1, At, B1); PG8_BAR; PG8_SCHED;
        }
        if (wr == 0) PG8_BAR;
        if constexpr (!Epi::AFTER_DRAIN) E(acc, cur, wr, wc, fr, fq);
        if (!has_next) break;
        if (!E.keep(cur))
#pragma unroll
        for (int a = 0; a < 2; ++a)
#pragma unroll
            for (int b = 0; b < 2; ++b)
#pragma unroll
                for (int m = 0; m < 4; ++m)
#pragma unroll
                    for (int n = 0; n < 2; ++n) acc[a][b][m][n] = (f32x4){0.f, 0.f, 0.f, 0.f};
        cur = nxt; cA = nA; cB = nB; ++ui;
        if (wr == 1) PG8_BAR;
    }
    PG8_WAIT_V(0);
    PG8_BAR;
    if constexpr (Epi::AFTER_DRAIN) E.fused(acc, cur, wr, wc, fr, fq, lds, wid, lane);
#undef PG8_SA
#undef PG8_SB
#undef PG8_STAGE2
#undef PG8_LDA
#undef PG8_LDB
#undef PG8_MMA
#undef PG8_WAIT_V
#undef PG8_WAIT_L
#undef PG8_BAR
#undef PG8_SCHED
}

struct EpiProj { static constexpr bool AFTER_DRAIN = false;
    bf16_t* O; const float* rope; int pn_off;
    __device__ __forceinline__ bool keep(const Unit&) const { return false; }
    __device__ __forceinline__ void operator()(const f32x4 (&acc)[2][2][4][2], const Unit& u, int wr, int wc, int fr, int fq) const {
        const int pn = u.pn + pn_off;
        const int row0 = u.pm * BM + wr * 64 + fr, col0 = pn * BM + wc * 32 + 8 * fq;
        const bool isrope = (pn >= 16 && pn < 24);
        const float qs = (pn >= 16 && pn < 20) ? 0.18033688011112042f : 1.0f;
#pragma unroll
        for (int ai = 0; ai < 2; ++ai)
#pragma unroll
            for (int m = 0; m < 4; ++m) {
                const int row = row0 + ai * HALF + m * 16;
                bf16_t* rowp = O + (size_t)row * NP + col0;
#pragma unroll
                for (int bj = 0; bj < 2; ++bj) {
                    f32x4 v0 = acc[ai][bj][m][0], v1 = acc[ai][bj][m][1];
                    if (isrope && ((wc & 1) == 0)) {
                        f32x4 p0, p1;
                        p0[0] = __shfl_xor(v0[0], 16); p0[1] = __shfl_xor(v0[1], 16); p0[2] = __shfl_xor(v0[2], 16); p0[3] = __shfl_xor(v0[3], 16);
                        p1[0] = __shfl_xor(v1[0], 16); p1[1] = __shfl_xor(v1[1], 16); p1[2] = __shfl_xor(v1[2], 16); p1[3] = __shfl_xor(v1[3], 16);
                        if (fq < 2) {
                            const f32x4 c0 = *(const f32x4*)(rope + (size_t)row * 16), c1 = *(const f32x4*)(rope + (size_t)row * 16 + 4);
                            const f32x4 s0 = *(const f32x4*)(rope + (size_t)row * 16 + 8), s1 = *(const f32x4*)(rope + (size_t)row * 16 + 12);
                            const float sg = (fq == 0) ? -1.0f : 1.0f;
                            v0 = v0 * c0 + (p0 * s0) * sg; v1 = v1 * c1 + (p1 * s1) * sg;
                        }
                    }
                    if (isrope) { v0 = v0 * qs; v1 = v1 * qs; }
                    u32x4 w; w.x = pk2(v0[0], v0[1]); w.y = pk2(v0[2], v0[3]); w.z = pk2(v1[0], v1[1]); w.w = pk2(v1[2], v1[3]);
                    if (pn >= 44) __builtin_nontemporal_store(w, (u32x4*)(rowp + bj * HALF)); else *(u32x4*)(rowp + bj * HALF) = w;
                    asm volatile("" ::: "memory");
                }
            }
    }
};
struct EpiMerge { static constexpr bool AFTER_DRAIN = false;
    const bf16_t* proj; bf16_t* YB;
    __device__ __forceinline__ bool keep(const Unit& u) const { return u.z < 2; }
    static __device__ __forceinline__ float e1(float x) { return 1.0f + __expf(-fminf(fmaxf(x, -60.f), 60.f)); }
    __device__ __forceinline__ void operator()(f32x4 (&acc)[2][2][4][2], const Unit& u, int wr, int wc, int fr, int fq) const {
        const int row0 = u.pm * BM + wr * 64 + fr, col0 = u.pn * BM + wc * 32 + 8 * fq;
#pragma unroll
        for (int ai = 0; ai < 2; ++ai)
#pragma unroll
            for (int m = 0; m < 4; ++m) {
                const int row = row0 + ai * HALF + m * 16;
#pragma unroll
                for (int bj = 0; bj < 2; ++bj) {
                    const int col = col0 + bj * HALF;
                    const bf16_t* gp = proj + (size_t)row * NP + C_GATE + u.z * D + col;
                    const u32x4 ga = *(const u32x4*)gp;
                    float sc[8];
                    { float a[8]; unpack8(ga, a);
#pragma unroll
                      for (int j = 0; j < 8; ++j) sc[j] = __builtin_amdgcn_rcpf(e1(a[j])); }
                    if (u.z < 2) { const u32x4 gb = *(const u32x4*)(gp + D); float b[8]; unpack8(gb, b);
#pragma unroll
                      for (int j = 0; j < 8; ++j) sc[j] *= e1(b[j]); }
                    f32x4 v0 = acc[ai][bj][m][0], v1 = acc[ai][bj][m][1];
                    v0[0] *= sc[0]; v0[1] *= sc[1]; v0[2] *= sc[2]; v0[3] *= sc[3]; v1[0] *= sc[4]; v1[1] *= sc[5]; v1[2] *= sc[6]; v1[3] *= sc[7];
                    if (u.z < 2) { acc[ai][bj][m][0] = v0; acc[ai][bj][m][1] = v1; }
                    else { u32x4 w; w.x = pk2(v0[0], v0[1]); w.y = pk2(v0[2], v0[3]); w.z = pk2(v1[0], v1[1]); w.w = pk2(v1[2], v1[3]); *(u32x4*)(YB + (size_t)row * D + col) = w; }
                    asm volatile("" ::: "memory");
                }
            }
    }
};
struct EpiResid { static constexpr bool AFTER_DRAIN = false;
    const bf16_t* H; bf16_t* TF;
    __device__ __forceinline__ bool keep(const Unit&) const { return false; }
    __device__ __forceinline__ void operator()(const f32x4 (&acc)[2][2][4][2], const Unit& u, int wr, int wc, int fr, int fq) const {
        const int row0 = u.pm * BM + wr * 64 + fr, col0 = u.pn * BM + wc * 32 + 8 * fq;
#pragma unroll
        for (int ai = 0; ai < 2; ++ai)
#pragma unroll
            for (int m = 0; m < 4; ++m) {
                const int row = row0 + ai * HALF + m * 16;
#pragma unroll
                for (int bj = 0; bj < 2; ++bj) {
                    const size_t o = (size_t)row * D + col0 + bj * HALF;
                    const u32x4 hb = *(const u32x4*)(H + o);
                    const f32x4 h0 = {bflo(hb.x), bfhi(hb.x), bflo(hb.y), bfhi(hb.y)}, h1 = {bflo(hb.z), bfhi(hb.z), bflo(hb.w), bfhi(hb.w)};
                    const f32x4 t0 = h0 * ALPHA + acc[ai][bj][m][0], t1 = h1 * ALPHA + acc[ai][bj][m][1];
                    u32x4 w; w.x = pk2(t0[0], t0[1]); w.y = pk2(t0[2], t0[3]); w.z = pk2(t1[0], t1[1]); w.w = pk2(t1[2], t1[3]);
                    *(u32x4*)(TF + o) = w;
                    asm volatile("" ::: "memory");
                }
            }
    }
};
struct EpiRelu2 { static constexpr bool AFTER_DRAIN = false;
    bf16_t* O;
    __device__ __forceinline__ bool keep(const Unit&) const { return false; }
    __device__ __forceinline__ void operator()(const f32x4 (&acc)[2][2][4][2], const Unit& u, int wr, int wc, int fr, int fq) const {
        const int row0 = u.pm * BM + wr * 64 + fr, col0 = u.pn * BM + wc * 32 + 8 * fq;
#pragma unroll
        for (int ai = 0; ai < 2; ++ai)
#pragma unroll
            for (int m = 0; m < 4; ++m) {
                bf16_t* rowp = O + (size_t)(row0 + ai * HALF + m * 16) * FF + col0;
#pragma unroll
                for (int bj = 0; bj < 2; ++bj) {
                    f32x4 v0 = acc[ai][bj][m][0], v1 = acc[ai][bj][m][1];
                    v0[0] = fmaxf(v0[0], 0.f); v0[1] = fmaxf(v0[1], 0.f); v0[2] = fmaxf(v0[2], 0.f); v0[3] = fmaxf(v0[3], 0.f);
                    v1[0] = fmaxf(v1[0], 0.f); v1[1] = fmaxf(v1[1], 0.f); v1[2] = fmaxf(v1[2], 0.f); v1[3] = fmaxf(v1[3], 0.f);
                    v0 = v0 * v0; v1 = v1 * v1;
                    u32x4 w; w.x = pk2(v0[0], v0[1]); w.y = pk2(v0[2], v0[3]); w.z = pk2(v1[0], v1[1]); w.w = pk2(v1[2], v1[3]);
                    *(u32x4*)(rowp + bj * HALF) = w;
                    asm volatile("" ::: "memory");
                }
            }
    }
};

struct PanelStats8 {
    unsigned long long* xbuf; unsigned* cnt; float eps;
    __device__ __forceinline__ void run(const f32x4 (&v)[2][2][4][2], const Unit& u, int wr, int wc, int fr, int fq, LAS unsigned char* lds, int wid, int lane) const {
        typedef float f32x2v __attribute__((ext_vector_type(2)));
        LAS f32x2v* Pt = (LAS f32x2v*)lds;
        LAS f32x2v* St = (LAS f32x2v*)(lds + 8192);
#pragma unroll
        for (int ai = 0; ai < 2; ++ai)
#pragma unroll
            for (int m = 0; m < 4; ++m) {
                float s = 0.f;
#pragma unroll
                for (int bj = 0; bj < 2; ++bj)
#pragma unroll
                    for (int n = 0; n < 2; ++n) { const f32x4 x = v[ai][bj][m][n]; s += (x[0] + x[1]) + (x[2] + x[3]); }
                s += __shfl_xor(s, 16); s += __shfl_xor(s, 32);
                const float mw = s * (1.0f / 64.0f); float q = 0.f;
#pragma unroll
                for (int bj = 0; bj < 2; ++bj)
#pragma unroll
                    for (int n = 0; n < 2; ++n) { const f32x4 d = v[ai][bj][m][n] - mw; q += (d[0] * d[0] + d[1] * d[1]) + (d[2] * d[2] + d[3] * d[3]); }
                q += __shfl_xor(q, 16); q += __shfl_xor(q, 32);
                if (fq == 0) Pt[(ai * HALF + wr * 64 + m * 16 + fr) * 4 + wc] = (f32x2v){mw, q};
            }
        asm volatile("s_waitcnt lgkmcnt(0)" ::: "memory"); __builtin_amdgcn_s_barrier(); asm volatile("" ::: "memory");
        const int row = wid * 32 + (lane & 31);
        if (lane < 32) {
            const f32x2v a = Pt[row * 4 + 0], b = Pt[row * 4 + 1], c = Pt[row * 4 + 2], d = Pt[row * 4 + 3];
            const float mt = (a.x + b.x + c.x + d.x) * 0.25f;
            const float da = a.x - mt, db = b.x - mt, dc = c.x - mt, dd = d.x - mt;
            const float m2 = (a.y + b.y) + (c.y + d.y) + 64.0f * ((da * da + db * db) + (dc * dc + dd * dd));
            unsigned long long* slot = xbuf + ((size_t)(u.pm * BM + row) * 8 + u.pn);
            __hip_atomic_store(slot, ((unsigned long long)__builtin_bit_cast(unsigned, m2) << 32) | __builtin_bit_cast(unsigned, mt), __ATOMIC_RELAXED, __HIP_MEMORY_SCOPE_AGENT);
        }
        asm volatile("s_waitcnt vmcnt(0)" ::: "memory");
        if (lane == 0) __hip_atomic_fetch_add(cnt + 64 * u.pm, 1u, __ATOMIC_RELAXED, __HIP_MEMORY_SCOPE_AGENT);
        if (wid == 0) {
            unsigned spins = 0;
            for (;;) {
                if ((unsigned)__builtin_amdgcn_readfirstlane(__hip_atomic_load(cnt + 64 * u.pm, __ATOMIC_RELAXED, __HIP_MEMORY_SCOPE_AGENT)) >= 64u) break;
                if (++spins > (1u << 22)) break;
            }
            __builtin_amdgcn_fence(__ATOMIC_ACQUIRE, "agent");
        }
        asm volatile("s_waitcnt vmcnt(0) lgkmcnt(0)" ::: "memory"); __builtin_amdgcn_s_barrier(); asm volatile("" ::: "memory");
        if (lane < 32) {
            const unsigned long long* slot = xbuf + (size_t)(u.pm * BM + row) * 8; float mt[8], m2[8]; float ms = 0.f;
#pragma unroll
            for (int t = 0; t < 8; ++t) { const unsigned long long w = __hip_atomic_load(slot + t, __ATOMIC_RELAXED, __HIP_MEMORY_SCOPE_AGENT); mt[t] = __builtin_bit_cast(float, (unsigned)w); m2[t] = __builtin_bit_cast(float, (unsigned)(w >> 32)); ms += mt[t]; }
            const float mean = ms * 0.125f; float q = 0.f;
#pragma unroll
            for (int t = 0; t < 8; ++t) { const float dm = mt[t] - mean; q += m2[t] + 256.0f * dm * dm; }
            St[row] = (f32x2v){mean, 1.0f / sqrtf(q * (1.0f / 2048.0f) + eps)};
        }
        asm volatile("s_waitcnt lgkmcnt(0)" ::: "memory"); __builtin_amdgcn_s_barrier(); asm volatile("" ::: "memory");
    }
};
template <bool OUT_F32, bool GATES>
struct EpiLn { static constexpr bool AFTER_DRAIN = true; static constexpr int DRAIN = 0;
    const bf16_t* H; const float* w; const float* b; bf16_t* outB; float* outF; PanelStats8 st;
    const float* win_next; const float* gbias; float* gpart;
    __device__ __forceinline__ bool keep(const Unit&) const { return false; }
    __device__ __forceinline__ void fused(f32x4 (&acc)[2][2][4][2], const Unit& u, int wr, int wc, int fr, int fq, LAS unsigned char* lds, int wid, int lane) const {
        typedef float f32x2v __attribute__((ext_vector_type(2)));
        const LAS f32x2v* St = (const LAS f32x2v*)(lds + 8192);
        const int col0 = u.pn * BM + wc * 32 + 8 * fq;
#pragma unroll
        for (int ai = 0; ai < 2; ++ai)
#pragma unroll
            for (int m = 0; m < 4; ++m) {
                const size_t ro = (size_t)(u.pm * BM + ai * HALF + wr * 64 + m * 16 + fr) * D + col0;
#pragma unroll
                for (int bj = 0; bj < 2; ++bj) {
                    const u32x4 hb = *(const u32x4*)(H + ro + bj * HALF);
                    const f32x4 h0 = {bflo(hb.x), bfhi(hb.x), bflo(hb.y), bfhi(hb.y)}, h1 = {bflo(hb.z), bfhi(hb.z), bflo(hb.w), bfhi(hb.w)};
                    acc[ai][bj][m][0] = h0 * ALPHA + acc[ai][bj][m][0]; acc[ai][bj][m][1] = h1 * ALPHA + acc[ai][bj][m][1];
                }
                if (m & 1) asm volatile("" ::: "memory");
            }
        if (GATES) {
            LAS float* wgl = (LAS float*)(lds + 16384);
            const int tid_ = wid * 64 + lane;
            if (tid_ < 256) { const float* src = win_next + (size_t)(u.pn * BM + tid_) * NSRC + 4096; const f32x4 a = *(const f32x4*)src, c = *(const f32x4*)(src + 4);
                wgl[0 * 256 + tid_] = a[0]; wgl[1 * 256 + tid_] = a[1]; wgl[2 * 256 + tid_] = a[2]; wgl[3 * 256 + tid_] = a[3];
                wgl[4 * 256 + tid_] = c[0]; wgl[5 * 256 + tid_] = c[1]; wgl[6 * 256 + tid_] = c[2]; wgl[7 * 256 + tid_] = c[3]; }
        }
        st.run(acc, u, wr, wc, fr, fq, lds, wid, lane);
#pragma unroll
        for (int bj = 0; bj < 2; ++bj) {
            const f32x4 w0 = *(const f32x4*)(w + col0 + bj * HALF), w1 = *(const f32x4*)(w + col0 + bj * HALF + 4);
            const f32x4 b0 = *(const f32x4*)(b + col0 + bj * HALF), b1 = *(const f32x4*)(b + col0 + bj * HALF + 4);
#pragma unroll
            for (int ai = 0; ai < 2; ++ai)
#pragma unroll
                for (int m = 0; m < 4; ++m) {
                    const int r = ai * HALF + wr * 64 + m * 16 + fr; const f32x2v sr = St[r];
                    const size_t o = (size_t)(u.pm * BM + r) * D + col0 + bj * HALF;
                    const f32x4 o0 = ((acc[ai][bj][m][0] - sr.x) * sr.y) * w0 + b0, o1 = ((acc[ai][bj][m][1] - sr.x) * sr.y) * w1 + b1;
                    if (OUT_F32) { *(f32x4*)(outF + o) = o0; *(f32x4*)(outF + o + 4) = o1; }
                    else { u32x4 pw; pw.x = pk2(o0[0], o0[1]); pw.y = pk2(o0[2], o0[3]); pw.z = pk2(o1[0], o1[1]); pw.w = pk2(o1[2], o1[3]); *(u32x4*)(outB + o) = pw; }
                    if (GATES) { acc[ai][bj][m][0] = o0; acc[ai][bj][m][1] = o1; }
                    asm volatile("" ::: "memory");
                }
        }
        if (GATES) {
            const LAS float* wgl = (const LAS float*)(lds + 16384);
            LAS float* GP = (LAS float*)(lds + 32768);
#pragma unroll 1
            for (int g = 0; g < 8; ++g) {
                const LAS float* wq = wgl + g * 256 + wc * 32 + 8 * fq;
                const f32x4 q00 = *(const LAS f32x4*)(wq), q01 = *(const LAS f32x4*)(wq + 4), q10 = *(const LAS f32x4*)(wq + HALF), q11 = *(const LAS f32x4*)(wq + HALF + 4);
#pragma unroll
                for (int ai = 0; ai < 2; ++ai)
#pragma unroll
                    for (int m = 0; m < 4; ++m) {
                        const f32x4 a0 = acc[ai][0][m][0] * q00 + acc[ai][0][m][1] * q01 + acc[ai][1][m][0] * q10 + acc[ai][1][m][1] * q11;
                        float p = (a0[0] + a0[1]) + (a0[2] + a0[3]);
                        p += __shfl_xor(p, 16); p += __shfl_xor(p, 32);
                        if (fq == 0) GP[((ai * HALF + wr * 64 + m * 16 + fr) * 8 + g) * 4 + wc] = p;
                    }
            }
            asm volatile("s_waitcnt lgkmcnt(0)" ::: "memory"); __builtin_amdgcn_s_barrier(); asm volatile("" ::: "memory");
            const int tid_ = wid * 64 + lane;
#pragma unroll
            for (int i = 0; i < 4; ++i) {
                const int idx = tid_ + 512 * i, row = idx >> 3, g = idx & 7;
                const f32x4 pp = *(const LAS f32x4*)(GP + idx * 4);
                float v = (pp[0] + pp[1]) + (pp[2] + pp[3]);
                if (u.pn == 0) v += gbias[g];
                gpart[(size_t)u.pn * T * 8 + (size_t)(u.pm * BM + row) * 8 + g] = v;
            }
        }
    }
};
}

__device__ __forceinline__ void tr_item(const float* W, int ldw, int src_c0, bf16_t* WT, int K, int n0, int k0, LAS float* scr, int lane) {
    const int r4 = lane >> 4, c4 = (lane & 15) * 4;
#pragma unroll 8
    for (int it = 0; it < 16; ++it) { const int kk = 4 * it + r4; const f32x4 v = __builtin_nontemporal_load((const f32x4*)(W + (size_t)(k0 + kk) * ldw + src_c0 + c4));
        LAS float* d = scr + kk * 65 + c4; d[0] = v[0]; d[1] = v[1]; d[2] = v[2]; d[3] = v[3]; }
    LDS_WAIT();
    const int c = lane & 7;
#pragma unroll
    for (int j = 0; j < 8; ++j) { const int n = (lane >> 3) + 8 * j; const LAS float* s = scr + (8 * c) * 65 + n;
        u32x4 o; o.x = pk2(s[0 * 65], s[1 * 65]); o.y = pk2(s[2 * 65], s[3 * 65]); o.z = pk2(s[4 * 65], s[5 * 65]); o.w = pk2(s[6 * 65], s[7 * 65]);
        *(u32x4*)(WT + (size_t)(n0 + n) * K + k0 + 8 * c) = o; }
    LDS_WAIT();
}
__device__ __forceinline__ void tr_matrix_item(const float* W, int K, int N, int ldw, bool skip8, bf16_t* WT, int item, LAS float* scr, int lane) {
    const int nblk = N / 64, kb = item / nblk, nb = item % nblk, n0 = nb * 64;
    const int src = n0 + ((skip8 && n0 >= 4096) ? 8 : 0);
    tr_item(W, ldw, src, WT, K, n0, kb * 64, scr, lane);
}

template <bool GATES, bool WRITE_B, bool WRITE_F, bool SRC_BF16>
__device__ __forceinline__ void ln_phase(const float* src, const float* w, const float* b, float* dstF, bf16_t* dstB,
                                         const float* win_l  , const float* gate_b, float* gif, LAS unsigned char* lds, int G) {
    const int tid = launder_i(threadIdx.x), lane = tid & 63, wid = tid >> 6;
    LAS float* wg = (LAS float*)lds;
    if (GATES) {
        for (int k = tid; k < D; k += NTHREADS) {
            const f32x4 a = *(const f32x4*)(win_l + (size_t)k * NSRC + 4096), c = *(const f32x4*)(win_l + (size_t)k * NSRC + 4100);
            wg[0 * D + k] = a[0]; wg[1 * D + k] = a[1]; wg[2 * D + k] = a[2]; wg[3 * D + k] = a[3];
            wg[4 * D + k] = c[0]; wg[5 * D + k] = c[1]; wg[6 * D + k] = c[2]; wg[7 * D + k] = c[3];
        }
        __syncthreads();
    }
    const int rstep = G * NWAVES, row_first = blockIdx.x * NWAVES + wid;
    u32x2 rawb[8]; f32x4 rawf[8];
    if (row_first < T) {
#pragma unroll
        for (int j = 0; j < 8; ++j) { if (SRC_BF16) rawb[j] = *(const u32x2*)((const bf16_t*)src + (size_t)row_first * D + 256 * j + 4 * lane); else rawf[j] = *(const f32x4*)(src + (size_t)row_first * D + 256 * j + 4 * lane); }
    }
    for (int row = row_first; row < T; row += rstep) {
        f32x4 v[8]; float s = 0.f;
#pragma unroll
        for (int j = 0; j < 8; ++j) {
            if (SRC_BF16) v[j] = (f32x4){bflo(rawb[j].x), bfhi(rawb[j].x), bflo(rawb[j].y), bfhi(rawb[j].y)}; else v[j] = rawf[j];
            s += (v[j][0] + v[j][1]) + (v[j][2] + v[j][3]);
        }
        if (row + rstep < T) {
#pragma unroll
            for (int j = 0; j < 8; ++j) { if (SRC_BF16) rawb[j] = *(const u32x2*)((const bf16_t*)src + (size_t)(row + rstep) * D + 256 * j + 4 * lane); else rawf[j] = *(const f32x4*)(src + (size_t)(row + rstep) * D + 256 * j + 4 * lane); }
        }
        const float mean = wave_sum(s) * (1.0f / D); float s2 = 0.f;
#pragma unroll
        for (int j = 0; j < 8; ++j) { v[j] = v[j] - mean; s2 += (v[j][0] * v[j][0] + v[j][1] * v[j][1]) + (v[j][2] * v[j][2] + v[j][3] * v[j][3]); }
        const float rstd = 1.0f / sqrtf(wave_sum(s2) * (1.0f / D) + LN_EPS);
#pragma unroll
        for (int j = 0; j < 8; ++j) {
            const f32x4 wvj = *(const f32x4*)(w + 256 * j + 4 * lane), bvj = *(const f32x4*)(b + 256 * j + 4 * lane);
            v[j] = (v[j] * rstd) * wvj + bvj;
            if (WRITE_F) *(f32x4*)(dstF + (size_t)row * D + 256 * j + 4 * lane) = v[j];
            if (WRITE_B) { u32x2 o; o.x = pk2(v[j][0], v[j][1]); o.y = pk2(v[j][2], v[j][3]); *(u32x2*)(dstB + (size_t)row * D + 256 * j + 4 * lane) = o; }
        }
        if (GATES) {
            float mine = 0.f;
#pragma unroll 1
            for (int g = 0; g < 8; ++g) {
                float p = 0.f;
#pragma unroll
                for (int j = 0; j < 8; ++j) { const f32x4 q = *(const LAS f32x4*)(wg + g * D + 256 * j + 4 * lane); p += (v[j][0] * q[0] + v[j][1] * q[1]) + (v[j][2] * q[2] + v[j][3] * q[3]); }
                p = wave_sum(p);
                if (lane == g) mine = p + gate_b[g];
            }
            if (lane < 8) gif[(size_t)row * 8 + lane] = mine;
        }
    }
    if (GATES) __syncthreads();
}

typedef short v4i16_t __attribute__((ext_vector_type(4)));
__device__ __forceinline__ bf16x8 trfrag2(const LAS bf16_t* p0, const LAS bf16_t* p1) {
    const v4i16_t a = __builtin_amdgcn_ds_read_tr16_b64_v4i16((LAS v4i16_t*)p0), b = __builtin_amdgcn_ds_read_tr16_b64_v4i16((LAS v4i16_t*)p1);
    bf16x8 r; r[0] = a[0]; r[1] = a[1]; r[2] = a[2]; r[3] = a[3]; r[4] = b[0]; r[5] = b[1]; r[6] = b[2]; r[7] = b[3]; return r;
}
__device__ __forceinline__ bf16x8 trfrag(const LAS bf16_t* base, int ld, int row0, int col0, int lane) {
    const int g = lane >> 4, q = (lane & 15) >> 2, p = lane & 3;
    const LAS bf16_t* p0 = base + (row0 + 8 * g + q) * ld + col0 + 4 * p;
    return trfrag2(p0, p0 + 4 * ld);
}

__device__ __forceinline__ void mlstm_unit(int unit, int l, const bf16_t* proj, const float* gif, const float* conv_w, const float* conv_b, bf16_t* mpart, float* dpart, int gplanes, LAS unsigned char* lds) {
    const int tid = launder_i(threadIdx.x), lane = tid & 63, wid = __builtin_amdgcn_readfirstlane(tid >> 6);
    const int b = unit >> 4, h = (unit >> 2) & 3, dq = unit & 3;
    const int g = lane >> 4, c16 = lane & 15;
    LAS bf16_t* Q = (LAS bf16_t*)(lds);
    LAS bf16_t* KK = (LAS bf16_t*)(lds + 9216);
    LAS bf16_t* V1 = (LAS bf16_t*)(lds + 18432);
    LAS bf16_t* VW = (LAS bf16_t*)(lds + 52224);
    LAS bf16_t* ST = (LAS bf16_t*)(lds + 86016);
    LAS bf16_t* AS = (LAS bf16_t*)(lds + 122880);
    LAS float* CWL = (LAS float*)(lds + 132096);
    LAS float* tabs = (LAS float*)(lds + 134656);
    LAS float* nvec = tabs + 384;
    LAS float* dsum = nvec + 64;
    LAS float* qn = dsum + 128;
    LAS float* npart = qn + 64;
    for (int i = tid; i < 256 * 72 / 2; i += NTHREADS) ((LAS unsigned*)ST)[i] = 0u;
    if (tid < 64) nvec[tid] = 0.f;
    if (tid < 128) {
        const float* cw = conv_w + (size_t)l * 4 * 2048; const float* cb = conv_b + (size_t)l * 2048;
        const int gcol = (tid >> 6) * 1024 + h * 256 + dq * 64 + (tid & 63);
#pragma unroll
        for (int tap = 0; tap < 4; ++tap) CWL[tap * 128 + tid] = cw[tap * 2048 + gcol];
        CWL[4 * 128 + tid] = cb[gcol];
    }
    f32x4 ct[2][4];
#pragma unroll
    for (int a = 0; a < 2; ++a)
#pragma unroll
        for (int n = 0; n < 4; ++n) ct[a][n] = (f32x4){0.f, 0.f, 0.f, 0.f};
    const int dgi = tid & 15, run = tid >> 4, lcol = (dgi >> 3) * 1024 + h * 256 + dq * 64 + (dgi & 7) * 8;
    const bf16_t* pq = proj + ((size_t)b * SEQ + run * 2 - 3) * NP + lcol;
    const bf16_t* pv = proj + ((size_t)b * SEQ + (tid >> 3)) * NP + C_MV + h * 256 + (tid & 7) * 8;
    const float* pg = gif + ((size_t)b * SEQ + lane) * 8 + h;
    u32x4 pf[5], pfv[4]; float pfi = 0.f, pff = 0.f; float pgi7[7] = {0.f, 0.f, 0.f, 0.f, 0.f, 0.f, 0.f}, pgf7[7] = {0.f, 0.f, 0.f, 0.f, 0.f, 0.f, 0.f};
#pragma unroll
    for (int i = 0; i < 5; ++i) { if (run * 2 - 3 + i < 0) pf[i] = (u32x4){0u, 0u, 0u, 0u}; else pf[i] = *(const u32x4*)(pq + (size_t)i * NP); }
#pragma unroll
    for (int i = 0; i < 4; ++i) pfv[i] = *(const u32x4*)(pv + 64 * i);
    if (wid == 0) {
        float ipre = pg[0], fpre = pg[4];
        if (gplanes == 8) {
            float gi_[7], gf_[7];
#pragma unroll
            for (int gp = 0; gp < 7; ++gp) { gi_[gp] = pg[(size_t)(gp + 1) * T * 8]; gf_[gp] = pg[(size_t)(gp + 1) * T * 8 + 4]; }
#pragma unroll
            for (int gp = 0; gp < 7; ++gp) { ipre += gi_[gp]; fpre += gf_[gp]; }
        }
        float v = fminf(fpre, 0.f) - __logf(1.0f + __expf(-fabsf(fpre)));
#pragma unroll
        for (int off = 1; off < 64; off <<= 1) { const float tv = __shfl_up(v, off); if (lane >= off) v += tv; }
        const float Gc = __shfl(v, 63);
        tabs[lane] = v; tabs[64 + lane] = ipre; tabs[128 + lane] = __expf(Gc - v + ipre) * 0.0625f;
    }
    __syncthreads();
    for (int c = 0; c < SEQ / 64; ++c) {
        const int t0 = c * 64; const size_t rowbase = (size_t)b * SEQ + t0;
        const LAS float* bcum = tabs + (c & 1) * 192; const LAS float* ig = bcum + 64; const LAS float* wsc = bcum + 128;
        const float Gc = bcum[63];
        {
            float cwr[5][8];
#pragma unroll
            for (int tap = 0; tap < 5; ++tap) { const f32x4 a = *(const LAS f32x4*)(CWL + tap * 128 + dgi * 8), c2 = *(const LAS f32x4*)(CWL + tap * 128 + dgi * 8 + 4);
                cwr[tap][0] = a[0]; cwr[tap][1] = a[1]; cwr[tap][2] = a[2]; cwr[tap][3] = a[3]; cwr[tap][4] = c2[0]; cwr[tap][5] = c2[1]; cwr[tap][6] = c2[2]; cwr[tap][7] = c2[3]; }
            LAS bf16_t* dst = ((dgi >> 3) ? KK : Q) + (run * 2) * 72 + (dgi & 7) * 8;
#pragma unroll
            for (int i = 0; i < 2; ++i) {
                float a[8];
#pragma unroll
                for (int j = 0; j < 8; ++j) a[j] = cwr[4][j];
#pragma unroll
                for (int tap = 0; tap < 4; ++tap) { float xf[8]; unpack8(pf[i + tap], xf);
#pragma unroll
                    for (int j = 0; j < 8; ++j) a[j] += cwr[tap][j] * xf[j]; }
#pragma unroll
                for (int j = 0; j < 8; ++j) a[j] = siluf_(a[j]);
                u32x4 o; o.x = pk2(a[0], a[1]); o.y = pk2(a[2], a[3]); o.z = pk2(a[4], a[5]); o.w = pk2(a[6], a[7]);
                *(LAS u32x4*)(dst + i * 72) = o;
            }
            if (c > 0 && tid < 64) {
                float sn = 0.f;
#pragma unroll
                for (int w8 = 0; w8 < 8; ++w8) sn += npart[w8 * 64 + tid];
                nvec[tid] = __expf(tabs[((c - 1) & 1) * 192 + 63]) * nvec[tid] + sn;
            }
            const int tv = tid >> 3, eg = tid & 7; const float w = wsc[tv];
#pragma unroll
            for (int i = 0; i < 4; ++i) {
                *(LAS u32x4*)(V1 + tv * 264 + (eg + 8 * i) * 8) = pfv[i];
                float vf[8]; unpack8(pfv[i], vf);
                u32x4 o; o.x = pk2(vf[0] * w, vf[1] * w); o.y = pk2(vf[2] * w, vf[3] * w); o.z = pk2(vf[4] * w, vf[5] * w); o.w = pk2(vf[6] * w, vf[7] * w);
                *(LAS u32x4*)(VW + tv * 264 + (eg + 8 * i) * 8) = o;
            }
        }
        LBAR();
        if (c + 1 < SEQ / 64) {
            pq += (size_t)64 * NP; pv += (size_t)64 * NP; pg += 64 * 8;
#pragma unroll
            for (int i = 0; i < 5; ++i) pf[i] = *(const u32x4*)(pq + (size_t)i * NP);
#pragma unroll
            for (int i = 0; i < 4; ++i) pfv[i] = *(const u32x4*)(pv + 64 * i);
            if (wid == 0) { pfi = pg[0]; pff = pg[4];
                if (gplanes == 8) {
#pragma unroll
                    for (int gp = 0; gp < 7; ++gp) { pgi7[gp] = pg[(size_t)(gp + 1) * T * 8]; pgf7[gp] = pg[(size_t)(gp + 1) * T * 8 + 4]; }
                } }
        }
        {
            const int mt = wid >> 1, nt0 = (wid & 1) * 2;
            f32x4 s0 = {0.f, 0.f, 0.f, 0.f}, s1 = {0.f, 0.f, 0.f, 0.f};
#pragma unroll
            for (int ks = 0; ks < 2; ++ks) { const bf16x8 a = frag(Q, 72, mt, ks, lane); s0 = MFMA16(a, frag(KK, 72, nt0, ks, lane), s0); s1 = MFMA16(a, frag(KK, 72, nt0 + 1, ks, lane), s1); }
            float rs[4];
#pragma unroll
            for (int j = 0; j < 4; ++j) {
                const int t = 16 * mt + 4 * g + j; const float bt = bcum[t];
                const int sa = 16 * nt0 + c16, sb = sa + 16;
                const float va = (sa <= t) ? s0[j] * __expf(bt - bcum[sa] + ig[sa]) * 0.0625f : 0.f;
                const float vb = (sb <= t) ? s1[j] * __expf(bt - bcum[sb] + ig[sb]) * 0.0625f : 0.f;
                AS[t * 72 + sa] = (bf16_t)f2bf(va); AS[t * 72 + sb] = (bf16_t)f2bf(vb);
                rs[j] = sum16(va + vb);
            }
            if (c16 == 0) {
#pragma unroll
                for (int j = 0; j < 4; ++j) dsum[(wid & 1) * 64 + 16 * mt + 4 * g + j] = rs[j];
            }
            const int t = tid >> 3, part = tid & 7; float p = 0.f;
            { const u32x4 qv = *(const LAS u32x4*)(Q + t * 72 + part * 8); float qf[8]; unpack8(qv, qf);
#pragma unroll
              for (int j = 0; j < 8; ++j) p += qf[j] * nvec[part * 8 + j]; }
            p += __shfl_xor(p, 1); p += __shfl_xor(p, 2); p += __shfl_xor(p, 4);
            if (part == 0) qn[t] = p;
        }
        LBAR();
        {
            f32x4 o1[2][4], o2[2][4];
#pragma unroll
            for (int ei = 0; ei < 2; ++ei)
#pragma unroll
                for (int tt = 0; tt < 4; ++tt) { o1[ei][tt] = (f32x4){0.f, 0.f, 0.f, 0.f}; o2[ei][tt] = (f32x4){0.f, 0.f, 0.f, 0.f}; }
#pragma unroll
            for (int ks = 0; ks < 2; ++ks) {
                const bf16x8 av0 = trfrag(V1, 264, 32 * ks, 16 * (2 * wid), lane), av1 = trfrag(V1, 264, 32 * ks, 16 * (2 * wid + 1), lane);
                const bf16x8 as0 = frag(ST, 72, 2 * wid, ks, lane), as1 = frag(ST, 72, 2 * wid + 1, ks, lane);
#pragma unroll
                for (int tt = 0; tt < 4; ++tt) {
                    const bf16x8 ba = frag(AS, 72, tt, ks, lane), bq = frag(Q, 72, tt, ks, lane);
                    o1[0][tt] = MFMA16(av0, ba, o1[0][tt]); o1[1][tt] = MFMA16(av1, ba, o1[1][tt]);
                    o2[0][tt] = MFMA16(as0, bq, o2[0][tt]); o2[1][tt] = MFMA16(as1, bq, o2[1][tt]);
                }
            }
#pragma unroll
            for (int tt = 0; tt < 4; ++tt) {
                const int t = 16 * tt + c16; const float wI = __expf(bcum[t]);
                bf16_t* orow = mpart + (rowbase + t) * 1024 + h * 256 + 32 * wid + 4 * g;
                const f32x4 r0 = o1[0][tt] + o2[0][tt] * wI, r1 = o1[1][tt] + o2[1][tt] * wI;
                u32x2 w0, w1; w0.x = pk2(r0[0], r0[1]); w0.y = pk2(r0[2], r0[3]); w1.x = pk2(r1[0], r1[1]); w1.y = pk2(r1[2], r1[3]);
                *(u32x2*)(orow) = w0; *(u32x2*)(orow + 16) = w1;
            }
            if (tid < 64) dpart[(rowbase + tid) * 4 + h] = dsum[tid] + dsum[64 + tid] + __expf(bcum[tid]) * qn[tid];
        }
        {
            const float dec = __expf(Gc);
#pragma unroll
            for (int a = 0; a < 2; ++a)
#pragma unroll
                for (int n = 0; n < 4; ++n) ct[a][n] = ct[a][n] * dec;
#pragma unroll
            for (int ks = 0; ks < 2; ++ks) {
                const bf16x8 a0 = trfrag(VW, 264, 32 * ks, 16 * (2 * wid), lane), a1 = trfrag(VW, 264, 32 * ks, 16 * (2 * wid + 1), lane);
#pragma unroll
                for (int n = 0; n < 4; ++n) { const bf16x8 bk = trfrag(KK, 72, 32 * ks, 16 * n, lane); ct[0][n] = MFMA16(a0, bk, ct[0][n]); ct[1][n] = MFMA16(a1, bk, ct[1][n]); }
            }
#pragma unroll
            for (int a = 0; a < 2; ++a)
#pragma unroll
                for (int n = 0; n < 4; ++n)
#pragma unroll
                    for (int j = 0; j < 4; ++j) ST[(16 * (2 * wid + a) + 4 * g + j) * 72 + 16 * n + c16] = (bf16_t)f2bf(ct[a][n][j]);
            {
                float sn = 0.f;
#pragma unroll
                for (int i = 0; i < 8; ++i) sn += wsc[wid * 8 + i] * bf2f(KK[(wid * 8 + i) * 72 + lane]);
                npart[wid * 64 + lane] = sn;
            }
            if (wid == 0 && c + 1 < SEQ / 64) {
                LAS float* nb = tabs + ((c + 1) & 1) * 192;
#pragma unroll
                for (int gp = 0; gp < 7; ++gp) { pfi += pgi7[gp]; pff += pgf7[gp]; }
                float v = fminf(pff, 0.f) - __logf(1.0f + __expf(-fabsf(pff)));
#pragma unroll
                for (int off = 1; off < 64; off <<= 1) { const float tv = __shfl_up(v, off); if (lane >= off) v += tv; }
                const float Gn = __shfl(v, 63);
                nb[lane] = v; nb[64 + lane] = pfi; nb[128 + lane] = __expf(Gn - v + pfi) * 0.0625f;
            }
        }
        LBAR();
    }
}

__device__ __forceinline__ void hgrn_unit(int unit, int l, const bf16_t* proj, const float* lb_logits, bf16_t* hpart, LAS unsigned char* lds) {
    const int tid = launder_i(threadIdx.x), lane = tid & 63, wid = __builtin_amdgcn_readfirstlane(tid >> 6);
    const int b = unit >> 4, h = (unit >> 1) & 7, kh = unit & 1;
    const int g = lane >> 4, c16 = lane & 15;
    LAS bf16_t* QA = (LAS bf16_t*)(lds);
    LAS bf16_t* KA = (LAS bf16_t*)(lds + 4608);
    LAS bf16_t* KB = (LAS bf16_t*)(lds + 9216);
    LAS bf16_t* VV = (LAS bf16_t*)(lds + 13824);
    LAS bf16_t* AS = (LAS bf16_t*)(lds + 22528);
    LAS bf16_t* ST = (LAS bf16_t*)(lds + 25088);
    LAS float* GD = (LAS float*)(lds + 43520);
    for (int i = tid; i < 128 * 72 / 2; i += NTHREADS) ((LAS unsigned*)ST)[i] = 0u;
    f32x4 st[4];
#pragma unroll
    for (int n = 0; n < 4; ++n) st[n] = (f32x4){0.f, 0.f, 0.f, 0.f};
    const int t = lane & 31, kg = tid >> 5;
    float lbv[4];
#pragma unroll
    for (int j = 0; j < 4; ++j) {
        const int ch = h * 128 + kh * 64 + kg * 4 + j;
        lbv[j] = (l == 0) ? 0.f : 1.0f / (1.0f + expf(lb_logits[ch] - lb_logits[1024 + ch]));
    }
    const bf16_t* pb = proj + ((size_t)b * SEQ + t) * NP + h * 128;
    u32x2 pgf = *(const u32x2*)(pb + C_GF + kh * 64 + kg * 4), pgq = *(const u32x2*)(pb + C_GQ + kh * 64 + kg * 4); u32x4 pgi = *(const u32x4*)(pb + C_GI + kg * 8);
    __syncthreads();
    for (int c = 0; c < SEQ / 32; ++c) {
        {
            float gf[4] = {bflo(pgf.x), bfhi(pgf.x), bflo(pgf.y), bfhi(pgf.y)}, qf[4] = {bflo(pgq.x), bfhi(pgq.x), bflo(pgq.y), bfhi(pgq.y)};
            float lf[4], kk[4], qa[4], ka[4], kb[4];
#pragma unroll
            for (int j = 0; j < 4; ++j) { const float f = lbv[j] + (1.0f - lbv[j]) * sigmoidf_(gf[j]); lf[j] = __logf(fmaxf(f, 1e-30f)); kk[j] = 1.0f - f; }
#pragma unroll
            for (int off = 1; off < 32; off <<= 1)
#pragma unroll
                for (int j = 0; j < 4; ++j) { const float v = __shfl_up(lf[j], off, 32); if (t >= off) lf[j] += v; }
#pragma unroll
            for (int j = 0; j < 4; ++j) {
                const float Gk = __shfl(lf[j], 31, 32);
                qa[j] = siluf_(qf[j]) * __expf(lf[j]); ka[j] = kk[j] * __expf(fminf(-lf[j], 80.f)); kb[j] = kk[j] * __expf(Gk - lf[j]);
                if (t == 31) GD[kg * 4 + j] = __expf(Gk);
            }
            u32x2 o; o.x = pk2(qa[0], qa[1]); o.y = pk2(qa[2], qa[3]); *(LAS u32x2*)(QA + t * 72 + kg * 4) = o;
            o.x = pk2(ka[0], ka[1]); o.y = pk2(ka[2], ka[3]); *(LAS u32x2*)(KA + t * 72 + kg * 4) = o;
            o.x = pk2(kb[0], kb[1]); o.y = pk2(kb[2], kb[3]); *(LAS u32x2*)(KB + t * 72 + kg * 4) = o;
            *(LAS u32x4*)(VV + t * 136 + kg * 8) = pgi;
        }
        LBAR();
        if (c + 1 < SEQ / 32) { pb += (size_t)32 * NP; pgf = *(const u32x2*)(pb + C_GF + kh * 64 + kg * 4); pgq = *(const u32x2*)(pb + C_GQ + kh * 64 + kg * 4); pgi = *(const u32x4*)(pb + C_GI + kg * 8); }
        if (wid < 4) {
            const int mt = wid >> 1, nt = wid & 1; f32x4 s = {0.f, 0.f, 0.f, 0.f};
#pragma unroll
            for (int ks = 0; ks < 2; ++ks) s = MFMA16(frag(QA, 72, mt, ks, lane), frag(KA, 72, nt, ks, lane), s);
#pragma unroll
            for (int j = 0; j < 4; ++j) { const int tt = 16 * mt + 4 * g + j, ss = 16 * nt + c16; AS[tt * 40 + ss] = (bf16_t)f2bf(ss <= tt ? s[j] : 0.f); }
        }
        LBAR();
        const bf16x8 vfr = trfrag(VV, 136, 0, 16 * wid, lane);
        {
#pragma unroll
            for (int mt = 0; mt < 2; ++mt) {
                f32x4 a = {0.f, 0.f, 0.f, 0.f};
                a = MFMA16(vfr, frag(AS, 40, mt, 0, lane), a);
#pragma unroll
                for (int ks = 0; ks < 2; ++ks) a = MFMA16(frag(ST, 72, wid, ks, lane), frag(QA, 72, mt, ks, lane), a);
                { u32x2 w; w.x = pk2(a[0], a[1]); w.y = pk2(a[2], a[3]); *(u32x2*)(hpart + ((size_t)b * SEQ + c * 32 + 16 * mt + c16) * 1024 + h * 128 + 16 * wid + 4 * g) = w; }
            }
        }
        {
#pragma unroll
            for (int n = 0; n < 4; ++n) {
                const float dec = GD[16 * n + c16];
                st[n] = st[n] * dec;
                st[n] = MFMA16(vfr, trfrag(KB, 72, 0, 16 * n, lane), st[n]);
#pragma unroll
                for (int j = 0; j < 4; ++j) ST[(16 * wid + 4 * g + j) * 72 + 16 * n + c16] = (bf16_t)f2bf(st[n][j]);
            }
        }
        LBAR();
    }
}

__device__ __forceinline__ void attn_unit(int u, int l, const bf16_t* proj, const float* a_lambda, const float* a_norm_w, bf16_t* ha, LAS unsigned char* lds) {
    const int tid = launder_i(threadIdx.x), lane = tid & 63, wid = __builtin_amdgcn_readfirstlane(tid >> 6);
    const int a_ = u & 127, i_ = u >> 7, j_ = a_ >> 5, bh = a_ & 31;
    const int qb = (i_ == 0) ? 15 - j_ : ((i_ == 1) ? j_ : ((i_ == 2) ? 11 - j_ : 4 + j_)), b = bh >> 3, h = bh & 7, q0 = qb * 128;
    const int g = lane >> 4, c16 = lane & 15;
    const float lam_init = 0.8f - 0.6f * expf(-0.3f * (float)l);
    float lam;
    { const float* lv = a_lambda + (size_t)l * 256; const float s1 = wave_sum(lv[lane] * lv[64 + lane]), s2 = wave_sum(lv[128 + lane] * lv[192 + lane]); lam = expf(s1) - expf(s2) + lam_init; }
    const int qrow = q0 + 16 * wid + c16;
    bf16x8 qf[2][2];
#pragma unroll
    for (int n = 0; n < 2; ++n)
#pragma unroll
        for (int ks = 0; ks < 2; ++ks) qf[n][ks] = *(const bf16x8*)(proj + ((size_t)b * SEQ + qrow) * NP + C_AQ + h * 128 + n * 64 + ks * 32 + g * 8);
    float mrow[2] = {-1e30f, -1e30f}, lrow[2] = {0.f, 0.f}; f32x4 O[2][8];
#pragma unroll
    for (int n = 0; n < 2; ++n)
#pragma unroll
        for (int e = 0; e < 8; ++e) O[n][e] = (f32x4){0.f, 0.f, 0.f, 0.f};
    const int ntiles = 2 * qb + 2;
    const int lr = tid >> 4, lc = (tid & 15) * 8;
    const bf16_t* pk = proj + ((size_t)b * SEQ + lr) * NP + C_AK + h * 128 + lc;
    const bf16_t* pvv = proj + ((size_t)b * SEQ + lr) * NP + C_AV + h * 128 + lc;
    u32x4 rk0 = *(const u32x4*)pk, rk1 = *(const u32x4*)(pk + (size_t)32 * NP), rv0 = *(const u32x4*)pvv, rv1 = *(const u32x4*)(pvv + (size_t)32 * NP);
    __syncthreads();
    for (int jt = 0; jt < ntiles; ++jt) {
        LAS bf16_t* KS = (LAS bf16_t*)(lds + (jt & 1) * 17408);
        LAS bf16_t* VS = (LAS bf16_t*)(lds + 34816 + (jt & 1) * 18432);
        *(LAS u32x4*)(KS + lr * 136 + lc) = rk0; *(LAS u32x4*)(KS + (lr + 32) * 136 + lc) = rk1;
        *(LAS u32x4*)(VS + lr * 144 + lc) = rv0; *(LAS u32x4*)(VS + (lr + 32) * 144 + lc) = rv1;
        __syncthreads();
        if (jt + 1 < ntiles) { pk += (size_t)64 * NP; pvv += (size_t)64 * NP;
            rk0 = *(const u32x4*)pk; rk1 = *(const u32x4*)(pk + (size_t)32 * NP); rv0 = *(const u32x4*)pvv; rv1 = *(const u32x4*)(pvv + (size_t)32 * NP); }
        const bool need_mask = (jt * 64 + 63 > q0 + 16 * wid);
        union { bf16x8 v; unsigned w[4]; } pb[2][2];
#pragma unroll
        for (int n = 0; n < 2; ++n) {
            f32x4 s[4];
#pragma unroll
            for (int it = 0; it < 4; ++it) {
                s[it] = (f32x4){0.f, 0.f, 0.f, 0.f};
#pragma unroll
                for (int ks = 0; ks < 2; ++ks) s[it] = MFMA16(*(const LAS bf16x8*)(KS + (it * 16 + c16) * 136 + n * 64 + ks * 32 + g * 8), qf[n][ks], s[it]);
            }
            if (need_mask) {
#pragma unroll
                for (int it = 0; it < 4; ++it)
#pragma unroll
                    for (int r = 0; r < 4; ++r) { const int key = jt * 64 + 16 * it + 4 * g + r; if (key > qrow) s[it][r] = -1e30f; }
            }
            float mx = -1e30f;
#pragma unroll
            for (int it = 0; it < 4; ++it) mx = fmaxf(mx, fmaxf(fmaxf(s[it][0], s[it][1]), fmaxf(s[it][2], s[it][3])));
            mx = fmaxf(mx, __shfl_xor(mx, 16)); mx = fmaxf(mx, __shfl_xor(mx, 32));
            const float mnew = (mx > mrow[n] + 8.0f) ? mx : mrow[n];
            float ps = 0.f;
#pragma unroll
            for (int it = 0; it < 4; ++it)
#pragma unroll
                for (int r = 0; r < 4; ++r) { s[it][r] = __builtin_amdgcn_exp2f(s[it][r] - mnew); ps += s[it][r]; }
            ps += __shfl_xor(ps, 16); ps += __shfl_xor(ps, 32);
            if (__builtin_amdgcn_ballot_w64(mnew != mrow[n]) != 0ull) {
                const float alpha = __builtin_amdgcn_exp2f(mrow[n] - mnew);
                lrow[n] = lrow[n] * alpha;
#pragma unroll
                for (int e = 0; e < 8; ++e) O[n][e] = O[n][e] * alpha;
            }
            lrow[n] += ps; mrow[n] = mnew;
#pragma unroll
            for (int ks = 0; ks < 2; ++ks) {
                pb[n][ks].w[0] = pk2(s[2 * ks][0], s[2 * ks][1]); pb[n][ks].w[1] = pk2(s[2 * ks][2], s[2 * ks][3]);
                pb[n][ks].w[2] = pk2(s[2 * ks + 1][0], s[2 * ks + 1][1]); pb[n][ks].w[3] = pk2(s[2 * ks + 1][2], s[2 * ks + 1][3]);
            }
        }
#pragma unroll
        for (int ks = 0; ks < 2; ++ks) {
            const LAS bf16_t* vb = VS + (32 * ks + 4 * g + (c16 >> 2)) * 144 + 4 * (c16 & 3);
#pragma unroll
            for (int e = 0; e < 8; ++e) {
                const bf16x8 vf = trfrag2(vb + 16 * e, vb + 16 * 144 + 16 * e);
                O[0][e] = MFMA16(vf, pb[0][ks].v, O[0][e]); O[1][e] = MFMA16(vf, pb[1][ks].v, O[1][e]);
            }
        }
    }
    {
        const float i0 = 1.0f / lrow[0], i1 = lam / lrow[1]; float ss = 0.f;
#pragma unroll
        for (int e = 0; e < 8; ++e) { O[0][e] = O[0][e] * i0 - O[1][e] * i1; ss += (O[0][e][0] * O[0][e][0] + O[0][e][1] * O[0][e][1]) + (O[0][e][2] * O[0][e][2] + O[0][e][3] * O[0][e][3]); }
        ss += __shfl_xor(ss, 16); ss += __shfl_xor(ss, 32);
        const float rsn = 1.0f / sqrtf(ss * (1.0f / 128.0f) + NORM_EPS) * (1.0f - lam_init);
        bf16_t* orow = ha + ((size_t)b * SEQ + qrow) * 1024 + h * 128 + 4 * g;
        const float* nw = a_norm_w + l * 1024 + h * 128 + 4 * g;
#pragma unroll
        for (int e = 0; e < 8; ++e) {
            const f32x4 wv = *(const f32x4*)(nw + 16 * e);
            u32x2 w; w.x = pk2(O[0][e][0] * rsn * wv[0], O[0][e][1] * rsn * wv[1]); w.y = pk2(O[0][e][2] * rsn * wv[2], O[0][e][3] * rsn * wv[3]);
            *(u32x2*)(orow + 16 * e) = w;
        }
    }
}


#define XB_TMO      128
#define XB_XCNT(j)  (256  + 64 * (j))
#define XB_XSUB(j)  (1280 + 64 * (j))
#define XB_XGEN(j)  (2304 + 64 * (j))
#define XB_TOP      3328
#define XB_TOPGEN   3392
#define XCD_BAR_WORDS 3456
#define XB_SPIN_CAP (1u << 18)
__device__ __forceinline__ unsigned xb_ld(unsigned* p)              { return __hip_atomic_load(p, __ATOMIC_RELAXED, __HIP_MEMORY_SCOPE_AGENT); }
__device__ __forceinline__ unsigned xb_add(unsigned* p, unsigned v) { return __hip_atomic_fetch_add(p, v, __ATOMIC_RELAXED, __HIP_MEMORY_SCOPE_AGENT); }
__device__ __forceinline__ unsigned xb_xcc_id() { return (unsigned)__builtin_amdgcn_s_getreg((3 << 11) | 20) & 0xFu; }
#define XB_SPIN(cond, bar) do { unsigned _sp = 0; while (cond) { \
    if ((++_sp & 255u) == 0u) { if (xb_ld(&(bar)[XB_TMO])) break; if (_sp > XB_SPIN_CAP) { atomicAdd(&(bar)[XB_TMO], 1u); break; } } } } while (0)
struct XcdBarrier { unsigned* bar; unsigned x; volatile LAS unsigned* st; };
__device__ __forceinline__ XcdBarrier xcd_barrier_post(unsigned* bar, volatile LAS unsigned* st) {
    XcdBarrier b; b.bar = bar; b.x = xb_xcc_id(); b.st = st;
    if (threadIdx.x == 0) (void)xb_add(&bar[XB_XCNT(b.x)], 1u);
    return b;
}
__device__ __forceinline__ void xcd_barrier_complete(unsigned* bar, unsigned x, unsigned& nloc, unsigned& nx) {
    const unsigned G = gridDim.x * gridDim.y * gridDim.z;
    unsigned sum, cnt, mine, sp = 0u;
    for (;;) {
        sum = 0u; cnt = 0u; mine = 0u;
#pragma unroll
        for (unsigned j = 0; j < 16; ++j) { const unsigned c = xb_ld(&bar[XB_XCNT(j)]); sum += c; cnt += (c > 0u) ? 1u : 0u; mine = (j == x) ? c : mine; }
        if (sum == G) break;
        __builtin_amdgcn_s_sleep(1);
        if ((++sp & 255u) == 0u) { if (xb_ld(&bar[XB_TMO])) break; if (sp > XB_SPIN_CAP) { atomicAdd(&bar[XB_TMO], 1u); break; } }
    }
    nloc = mine > 0u ? mine : 1u; nx = cnt > 0u ? cnt : 1u;
}
__device__ __forceinline__ void xcd_barrier(const XcdBarrier& b) {
    asm volatile("s_waitcnt vmcnt(0)" ::: "memory");
    __syncthreads();
    if (threadIdx.x == 0) {
        unsigned* bar = b.bar;
        __builtin_amdgcn_s_waitcnt(0);
        unsigned nloc = b.st[0], nx = b.st[1];
        if (nloc == 0u) { xcd_barrier_complete(bar, b.x, nloc, nx); b.st[0] = nloc; b.st[1] = nx; }
        const unsigned old = xb_add(&bar[XB_XSUB(b.x)], 1u);
        const unsigned gen = old / nloc;
        if (old + 1u == (gen + 1u) * nloc) {
            __builtin_amdgcn_fence(__ATOMIC_RELEASE, "agent");
            asm volatile("s_waitcnt vmcnt(0)" ::: "memory");
            const unsigned og = xb_add(&bar[XB_TOP], 1u);
            const unsigned tg = og / nx;
            if (og + 1u == (tg + 1u) * nx) xb_add(&bar[XB_TOPGEN], 1u);
            else XB_SPIN(xb_ld(&bar[XB_TOPGEN]) == tg, bar);
            __builtin_amdgcn_fence(__ATOMIC_ACQUIRE, "agent");
            xb_add(&bar[XB_XGEN(b.x)], 1u);
            asm volatile("s_waitcnt vmcnt(0)" ::: "memory");
        } else {
            XB_SPIN(xb_ld(&bar[XB_XGEN(b.x)]) == gen, bar);
            __builtin_amdgcn_fence(__ATOMIC_ACQUIRE, "agent");
            asm volatile("s_waitcnt vmcnt(0)" ::: "memory");
        }
    }
    __syncthreads();
}

__global__ void __launch_bounds__(NTHREADS, 2) fwd_megakernel(Params P) {
    extern __shared__ __attribute__((aligned(16))) unsigned char lds_raw[];
    LAS unsigned char* lds = (LAS unsigned char*)lds_raw;
    cg::grid_group grid = cg::this_grid();
    volatile LAS unsigned* bst = (volatile LAS unsigned*)(lds + LDS_BYTES - 16);
    if (threadIdx.x == 0) { bst[0] = 0u; bst[1] = 0u; }
    __syncthreads();
    const XcdBarrier xbar = xcd_barrier_post((unsigned*)(KWS + WS_BAR), bst);
    const int G = gridDim.x, bid = blockIdx.x;
#define positions ((const int*)KIN(1))
#define w_in KIN(4)
#define conv_w KIN(5)
#define conv_b KIN(6)
#define gate_b KIN(7)
#define m_norm_w KIN(8)
#define a_lambda KIN(9)
#define a_norm_w KIN(10)
#define lb_logits KIN(11)
#define g_norm_w KIN(12)
#define B_Hf ((float*)(KWS + WS_H))
#define B_Hb ((bf16_t*)(KWS + WS_HB))
#define B_PROJ ((bf16_t*)(KWS + WS_PROJ))
#define B_ACT B_PROJ
#define B_HCAT ((bf16_t*)(KWS + WS_HCAT))
#define B_MPART ((bf16_t*)(KWS + WS_MPART))
#define B_DPART ((float*)(KWS + WS_DPART))
#define B_HPART ((bf16_t*)(KWS + WS_HPART))
#define B_YF ((float*)(KWS + WS_YF))
#define B_YB ((bf16_t*)(KWS + WS_YB))
#define B_TF ((float*)(KWS + WS_TF))
#define B_GIF ((float*)(KWS + WS_GPART))
#define B_ROPE ((float*)(KWS + WS_ROPE))
    {
        const int tid = launder_i(threadIdx.x), lane = tid & 63, wid = tid >> 6;
        LAS float* scr = (LAS float*)(lds + wid * 16640);
        const int gw = bid * NWAVES + wid, NGW = G * NWAVES;
        constexpr int I_IN = (D / 64) * (NP / 64), I_P = (1024 / 64) * (D / 64), I_O = (D / 64) * (D / 64), I_U = (D / 64) * (FF / 64), I_D = (FF / 64) * (D / 64);
        constexpr int I_L = I_IN + 3 * I_P + I_O + I_U + I_D;
        const float* q_win = KIN(4); const float* q_pm = KIN(13); const float* q_pa = KIN(14); const float* q_pg = KIN(15); const float* q_wo = KIN(16); const float* q_up = KIN(19); const float* q_dn = KIN(20);
        unsigned char* q_ws = KWS; const int* q_pos = (const int*)KIN(1);
        for (int rp0 = 0; rp0 < REP_P0; ++rp0)
        for (int it = gw; it < DEPTH * I_L; it += NGW) {
            const int l = it / I_L; int r = it % I_L;
            if (r < I_IN) { tr_matrix_item(q_win + (size_t)l * D * NSRC, D, NP, NSRC, true, (bf16_t*)(q_ws + WS_WIN + l * SZ_WIN), r, scr, lane); continue; } r -= I_IN;
            if (r < I_P) { tr_matrix_item(q_pm + (size_t)l * 1024 * D, 1024, D, D, false, (bf16_t*)(q_ws + WS_WPM + l * SZ_WP), r, scr, lane); continue; } r -= I_P;
            if (r < I_P) { tr_matrix_item(q_pa + (size_t)l * 1024 * D, 1024, D, D, false, (bf16_t*)(q_ws + WS_WPA + l * SZ_WP), r, scr, lane); continue; } r -= I_P;
            if (r < I_P) { tr_matrix_item(q_pg + (size_t)l * 1024 * D, 1024, D, D, false, (bf16_t*)(q_ws + WS_WPG + l * SZ_WP), r, scr, lane); continue; } r -= I_P;
            if (r < I_O) { tr_matrix_item(q_wo + (size_t)l * D * D, D, D, D, false, (bf16_t*)(q_ws + WS_WOUT + l * SZ_WOUT), r, scr, lane); continue; } r -= I_O;
            if (r < I_U) { tr_matrix_item(q_up + (size_t)l * D * FF, D, FF, FF, false, (bf16_t*)(q_ws + WS_WUP + l * SZ_WUP), r, scr, lane); continue; } r -= I_U;
            tr_matrix_item(q_dn + (size_t)l * FF * D, FF, D, D, false, (bf16_t*)(q_ws + WS_WDN + l * SZ_WDN), r, scr, lane);
        }
        for (int i = bid * NTHREADS + tid; i < T * 8; i += G * NTHREADS) {
            const int row = i >> 3, f = i & 7;
            const float inv = powf(500000.0f, -(float)(2 * f) / 16.0f);
            const float ang = (float)q_pos[row] * inv;
            float* q_rope = (float*)(q_ws + WS_ROPE); q_rope[row * 16 + f] = cosf(ang); q_rope[row * 16 + 8 + f] = sinf(ang);
        }
        __syncthreads();
        ln_phase<true, true, false, false>(KIN(0), KIN(2), KIN(3), nullptr, B_Hb, w_in, gate_b, B_GIF, lds, G);
    }
    xcd_barrier(xbar);
    if (G == 0x40000000) grid.sync();

#pragma unroll 1
    for (int l = 0; l < DEPTH; ++l) {
        {
            pg8::Sched S; S.init(T, 16384, D, 1, G, bid);
            S.strideA = S.strideB = 0; S.A0 = (const char*)B_Hb; S.B0 = (const char*)(KWS + WS_WIN + l * SZ_WIN);
            pg8::EpiProj E; E.O = B_PROJ; E.rope = B_ROPE; E.pn_off = 0;
#if !defined(SKIP_GEMM) && !defined(SKIP_G0)
            for (int rep = 0; rep < REP_GEMM; ++rep) pg8::gemm_phase(lds, S, E);
#endif
        }
        xcd_barrier(xbar);
        {
            const int gm = G / 4, gh = G / 4, ga = G - gm - gh;
            if (bid < gm) { for (int rep = 0; rep < REP_M; ++rep) for (int u0 = bid; u0 < 64; u0 += gm) { const int u = (gm == 64) ? (u0 & 7) * 8 + (u0 >> 3) : u0;
#ifndef SKIP_MLSTM
 mlstm_unit(u, l, B_PROJ, B_GIF, conv_w, conv_b, B_MPART + (size_t)(u & 3) * T * 1024, B_DPART + (size_t)(u & 3) * T * 4, (l > 0 && G == 256) ? 8 : 1, lds);
#endif
 } }
            else if (bid < gm + gh) { for (int rep = 0; rep < REP_H; ++rep) for (int u0 = bid - gm; u0 < 64; u0 += gh) { const int u = (gh == 64) ? (u0 & 7) * 8 + (u0 >> 3) : u0;
#ifndef SKIP_HGRN
 hgrn_unit(u, l, B_PROJ, lb_logits, B_HPART + (size_t)(u & 1) * T * 1024, lds);
#endif
 } }
            else { for (int rep = 0; rep < REP_A; ++rep) for (int u = bid - gm - gh; u < 512; u += ga) {
#ifndef SKIP_ATTN
 attn_unit(u, l, B_PROJ, a_lambda, a_norm_w, B_HCAT + (size_t)T * 1024, lds);
#endif
 }
                {
                    __syncthreads();
                    pg8::Sched S; S.init(T, 1024, D, 1, ga, bid - gm - gh);
                    S.strideA = S.strideB = 0; S.A0 = (const char*)B_Hb; S.B0 = (const char*)(KWS + WS_WIN + l * SZ_WIN + (size_t)16384 * D * 2);
                    pg8::EpiProj E; E.O = B_PROJ; E.rope = B_ROPE; E.pn_off = 64;
                    pg8::gemm_phase(lds, S, E);
                }
            }
        }
        xcd_barrier(xbar);
        { const int tid = launder_i(threadIdx.x), lane = tid & 63, wid = tid >> 6;
        const bf16_t* q_mp = B_MPART; const float* q_dp = B_DPART; const bf16_t* q_hp = B_HPART; const float* q_mnw = m_norm_w; const float* q_gnw = g_norm_w; const bf16_t* q_proj = B_PROJ; bf16_t* q_hcat = B_HCAT;
        const int step = G * NWAVES;
        for (int it0 = bid * NWAVES + wid; it0 < T * 4; it0 += 2 * step) {
            f32x4 v[2]; float den[2]; u32x2 mo[2]; bool ok[2];
#pragma unroll
            for (int q = 0; q < 2; ++q) {
                const int it = it0 + q * step; ok[q] = it < T * 4; const int itc = ok[q] ? it : it0;
                const int row = itc >> 2, h = itc & 3; const size_t o = (size_t)row * 1024 + h * 256 + 4 * lane;
                v[q] = (f32x4){0.f, 0.f, 0.f, 0.f}; den[q] = 0.f;
#pragma unroll
                for (int dq = 0; dq < 4; ++dq) { const u32x2 p = *(const u32x2*)(q_mp + (size_t)dq * T * 1024 + o);
                    v[q][0] += bflo(p.x); v[q][1] += bfhi(p.x); v[q][2] += bflo(p.y); v[q][3] += bfhi(p.y); den[q] += q_dp[(size_t)dq * T * 4 + (size_t)row * 4 + h]; }
                mo[q] = *(const u32x2*)(q_proj + (size_t)row * NP + C_MO + h * 256 + 4 * lane);
            }
#pragma unroll
            for (int q = 0; q < 2; ++q) {
                const int it = it0 + q * step; const int itc = ok[q] ? it : it0; const int row = itc >> 2, h = itc & 3;
                const f32x4 x = v[q] * (1.0f / fmaxf(fabsf(den[q]), 1.0f));
                const float ss = wave_sum((x[0] * x[0] + x[1] * x[1]) + (x[2] * x[2] + x[3] * x[3]));
                const float rsn = 1.0f / sqrtf(ss * (1.0f / 256.0f) + NORM_EPS);
                const f32x4 wn = *(const f32x4*)(q_mnw + l * 1024 + h * 256 + 4 * lane);
                u32x2 ow;
                ow.x = pk2(x[0] * rsn * wn[0] * sigmoidf_(bflo(mo[q].x)), x[1] * rsn * wn[1] * sigmoidf_(bfhi(mo[q].x)));
                ow.y = pk2(x[2] * rsn * wn[2] * sigmoidf_(bflo(mo[q].y)), x[3] * rsn * wn[3] * sigmoidf_(bfhi(mo[q].y)));
                if (ok[q]) *(u32x2*)(q_hcat + (size_t)row * 1024 + h * 256 + 4 * lane) = ow;
            }
        }
        for (int it0 = bid * NWAVES + wid; it0 < T * 4; it0 += 2 * step) {
            f32x4 v[2]; u32x2 gg[2]; bool ok[2];
#pragma unroll
            for (int q = 0; q < 2; ++q) {
                const int it = it0 + q * step; ok[q] = it < T * 4; const int itc = ok[q] ? it : it0;
                const int row = itc >> 2, hp = itc & 3; const size_t o = (size_t)row * 1024 + hp * 256 + 4 * lane;
                const u32x2 p0 = *(const u32x2*)(q_hp + o), p1 = *(const u32x2*)(q_hp + (size_t)T * 1024 + o);
                v[q][0] = bflo(p0.x) + bflo(p1.x); v[q][1] = bfhi(p0.x) + bfhi(p1.x); v[q][2] = bflo(p0.y) + bflo(p1.y); v[q][3] = bfhi(p0.y) + bfhi(p1.y);
                gg[q] = *(const u32x2*)(q_proj + (size_t)row * NP + C_GG + hp * 256 + 4 * lane);
            }
#pragma unroll
            for (int q = 0; q < 2; ++q) {
                const int it = it0 + q * step; const int itc = ok[q] ? it : it0; const int row = itc >> 2, hp = itc & 3; const size_t o = (size_t)row * 1024 + hp * 256 + 4 * lane;
                const f32x4 x = v[q];
                float ss = (x[0] * x[0] + x[1] * x[1]) + (x[2] * x[2] + x[3] * x[3]);
#pragma unroll
                for (int off = 1; off < 32; off <<= 1) ss += __shfl_xor(ss, off);
                const float rsn = 1.0f / sqrtf(ss * (1.0f / 128.0f) + NORM_EPS);
                const f32x4 wn = *(const f32x4*)(q_gnw + l * 1024 + hp * 256 + 4 * lane);
                u32x2 ow;
                ow.x = pk2(x[0] * rsn * wn[0] * siluf_(bflo(gg[q].x)), x[1] * rsn * wn[1] * siluf_(bfhi(gg[q].x)));
                ow.y = pk2(x[2] * rsn * wn[2] * siluf_(bflo(gg[q].y)), x[3] * rsn * wn[3] * siluf_(bfhi(gg[q].y)));
                if (ok[q]) *(u32x2*)(q_hcat + (size_t)2 * T * 1024 + o) = ow;
            }
        } }
        xcd_barrier(xbar);
        {
            pg8::Sched S; S.init(T, D, 1024, 3, G, bid);
            S.A0 = (const char*)B_HCAT; S.strideA = T * 1024 * 2;
            S.B0 = (const char*)(KWS + WS_WPM + l * SZ_WP); S.strideB = (int)(DEPTH * SZ_WP);
            pg8::EpiMerge E; E.proj = B_PROJ; E.YB = B_YB;
#if !defined(SKIP_GEMM) && !defined(SKIP_G1)
            for (int rep = 0; rep < REP_GEMM; ++rep) pg8::gemm_phase(lds, S, E);
#endif
        }
        xcd_barrier(xbar);
        {
            pg8::Sched S; S.init(T, D, D, 1, G, bid);
            S.strideA = S.strideB = 0; S.A0 = (const char*)B_YB; S.B0 = (const char*)(KWS + WS_WOUT + l * SZ_WOUT);
            if (G == 256) {
                pg8::EpiLn<false, false> E; E.H = B_Hb; E.w = KIN(17) + l * D; E.b = KIN(18) + l * D; E.outB = B_Hb; E.outF = nullptr; E.win_next = nullptr; E.gbias = nullptr; E.gpart = nullptr;
                E.st.xbuf = (unsigned long long*)(KWS + WS_XBUF) + (size_t)l * T * 8; E.st.cnt = (unsigned*)(KWS + WS_CNT) + l * 32 * 64; E.st.eps = LN_EPS;
                pg8::gemm_phase(lds, S, E);
            } else {
                pg8::EpiResid E; E.H = B_Hb; E.TF = (bf16_t*)B_TF;
                pg8::gemm_phase(lds, S, E);
            }
        }
        xcd_barrier(xbar);
        if (G != 256) {
            ln_phase<false, true, false, true>(B_TF, KIN(17) + l * D, KIN(18) + l * D, nullptr, B_Hb, nullptr, nullptr, nullptr, lds, G);
            xcd_barrier(xbar);
        }
        {
            pg8::Sched S; S.init(T, FF, D, 1, G, bid);
            S.strideA = S.strideB = 0; S.A0 = (const char*)B_Hb; S.B0 = (const char*)(KWS + WS_WUP + l * SZ_WUP);
            pg8::EpiRelu2 E; E.O = B_ACT;
#if !defined(SKIP_GEMM) && !defined(SKIP_G3)
            for (int rep = 0; rep < REP_GEMM; ++rep) pg8::gemm_phase(lds, S, E);
#endif
        }
        xcd_barrier(xbar);
        {
            pg8::Sched S; S.init(T, D, FF, 1, G, bid);
            S.strideA = S.strideB = 0; S.A0 = (const char*)B_ACT; S.B0 = (const char*)(KWS + WS_WDN + l * SZ_WDN);
            if (G == 256 && l + 1 == DEPTH) {
                pg8::EpiLn<true, false> E; E.H = B_Hb; E.w = KIN(21) + l * D; E.b = KIN(22) + l * D; E.outB = nullptr; E.outF = kparams()->out; E.win_next = nullptr; E.gbias = nullptr; E.gpart = nullptr;
                E.st.xbuf = (unsigned long long*)(KWS + WS_XBUF) + (size_t)DEPTH * T * 8; E.st.cnt = (unsigned*)(KWS + WS_CNT) + DEPTH * 32 * 64; E.st.eps = LN_EPS;
                pg8::gemm_phase(lds, S, E);
            } else if (G == 256) {
                pg8::EpiLn<false, true> E; E.H = B_Hb; E.w = KIN(21) + l * D; E.b = KIN(22) + l * D; E.outB = B_Hb; E.outF = nullptr;
                E.win_next = w_in + (size_t)(l + 1) * D * NSRC; E.gbias = gate_b + (l + 1) * 8; E.gpart = B_GIF;
                E.st.xbuf = (unsigned long long*)(KWS + WS_XBUF) + (size_t)(DEPTH + 1 + l) * T * 8; E.st.cnt = (unsigned*)(KWS + WS_CNT) + (DEPTH + 1 + l) * 32 * 64; E.st.eps = LN_EPS;
                pg8::gemm_phase(lds, S, E);
            } else {
                pg8::EpiResid E; E.H = B_Hb; E.TF = (bf16_t*)B_TF;
                pg8::gemm_phase(lds, S, E);
            }
        }
        if (G == 256 && l + 1 == DEPTH) break;
        xcd_barrier(xbar);
        if (G == 256) continue;
        if (l + 1 < DEPTH) {
            ln_phase<true, true, false, true>(B_TF, KIN(21) + l * D, KIN(22) + l * D, nullptr, B_Hb, w_in + (size_t)(l + 1) * D * NSRC, gate_b + (l + 1) * 8, B_GIF, lds, G);
            xcd_barrier(xbar);
        } else {
            ln_phase<false, false, true, true>(B_TF, KIN(21) + l * D, KIN(22) + l * D, kparams()->out, nullptr, nullptr, nullptr, nullptr, lds, G);
        }
    }
}

extern "C" void kernel_launch(void* const* d_in, const int* in_sizes, int n_in, void* d_out, int out_size, void* d_ws, size_t ws_size, hipStream_t stream) {
    static int grid_blocks = 0;
    if (grid_blocks == 0) {
        if (n_in != 23 || out_size != T * D || ws_size < WS_END) { fprintf(stderr, "kernel_launch: unexpected shapes (n_in %d out %d ws %zu need %zu)\n", n_in, out_size, ws_size, (size_t)WS_END); grid_blocks = -1; return; }
        int dev = 0, cus = 0, per_cu = 0;
        hipGetDevice(&dev);
        hipDeviceGetAttribute(&cus, hipDeviceAttributeMultiprocessorCount, dev);
        if (hipFuncSetAttribute((const void*)fwd_megakernel, hipFuncAttributeMaxDynamicSharedMemorySize, LDS_BYTES) != hipSuccess) { fprintf(stderr, "kernel_launch: hipFuncSetAttribute failed\n"); grid_blocks = -1; return; }
        hipOccupancyMaxActiveBlocksPerMultiprocessor(&per_cu, (const void*)fwd_megakernel, NTHREADS, LDS_BYTES);
        if (per_cu < 1) { fprintf(stderr, "kernel_launch: occupancy query says %d blocks per CU\n", per_cu); per_cu = 1; }
        (void)hipGetLastError();
        grid_blocks = cus * 1;
    }
    if (grid_blocks < 0) return;
    if (hipMemsetAsync((char*)d_ws + WS_BAR, 0, WS_ZERO_BYTES, stream) != hipSuccess) { fprintf(stderr, "kernel_launch: memset failed\n"); return; }
    Params p{};
    for (int i = 0; i < 23; ++i) p.in[i] = (const float*)d_in[i];
    p.out = (float*)d_out; p.wsp = (unsigned char*)d_ws;
    void* args[] = {&p};
    hipError_t e = hipLaunchCooperativeKernel((const void*)fwd_megakernel, dim3(grid_blocks), dim3(NTHREADS), args, LDS_BYTES, stream);
    if (e != hipSuccess) fprintf(stderr, "cooperative launch failed: %s (grid %d)\n", hipGetErrorString(e), grid_blocks);
}
```

```cpp
#include <hip/hip_runtime.h>
#include <hip/hip_cooperative_groups.h>
#include <cstdio>
#include <cstdint>
namespace cg = cooperative_groups;

#define LAS __attribute__((address_space(3)))
typedef unsigned short bf16_t;
typedef short bf16x8 __attribute__((ext_vector_type(8)));
typedef float f32x4 __attribute__((ext_vector_type(4)));
typedef unsigned u32x4 __attribute__((ext_vector_type(4)));
typedef unsigned u32x2 __attribute__((ext_vector_type(2)));

constexpr int T = 8192, SEQ = 2048, D = 2048, NP = 17408, NSRC = 17416, FF = 8192, DEPTH = 2;
constexpr int C_MQ = 0, C_MK = 1024, C_MV = 2048, C_MO = 3072, C_AQ = 4096, C_AK = 5120, C_AV = 6144, C_GQ = 7168, C_GF = 8192, C_GI = 9216, C_GG = 10240, C_GATE = 11264;
constexpr float ALPHA = 1.41421356237f;
constexpr float LN_EPS = 1e-5f, NORM_EPS = 1e-6f;
constexpr int NTHREADS = 512, NWAVES = 8;
constexpr int LDS_BYTES = 159744;
#ifndef REP_P0
#define REP_P0 1
#endif
#ifndef REP_GEMM
#define REP_GEMM 1
#endif
#ifndef REP_M
#define REP_M 1
#endif
#ifndef REP_H
#define REP_H 1
#endif
#ifndef REP_A
#define REP_A 1
#endif

constexpr size_t SZ_WIN = (size_t)NP * D * 2, SZ_WP = (size_t)2048 * 1024 * 2, SZ_WOUT = (size_t)D * D * 2, SZ_WUP = (size_t)FF * D * 2, SZ_WDN = (size_t)D * FF * 2;
constexpr size_t WS_WIN = 0;
constexpr size_t WS_WPM = WS_WIN + DEPTH * SZ_WIN;
constexpr size_t WS_WPA = WS_WPM + DEPTH * SZ_WP;
constexpr size_t WS_WPG = WS_WPA + DEPTH * SZ_WP;
constexpr size_t WS_WOUT = WS_WPG + DEPTH * SZ_WP;
constexpr size_t WS_WUP = WS_WOUT + DEPTH * SZ_WOUT;
constexpr size_t WS_WDN = WS_WUP + DEPTH * SZ_WUP;
constexpr size_t WS_H = WS_WDN + DEPTH * SZ_WDN;
constexpr size_t WS_HB = WS_H + (size_t)T * D * 4;
constexpr size_t WS_PROJ = WS_HB + (size_t)T * D * 2;
constexpr size_t WS_HCAT = WS_PROJ + (size_t)T * NP * 2;
constexpr size_t WS_HPART = WS_HCAT + (size_t)3 * T * 1024 * 2;
constexpr size_t WS_YF = WS_HPART + (size_t)2 * T * 1024 * 4;
constexpr size_t WS_YB = WS_YF + (size_t)T * D * 4;
constexpr size_t WS_TF = WS_YB + (size_t)T * D * 2;
constexpr size_t WS_MPART = WS_YF;
constexpr size_t WS_GIF = WS_TF + (size_t)T * D * 4;
constexpr size_t WS_ROPE = WS_GIF + (size_t)T * 8 * 4;
constexpr size_t WS_DPART = WS_ROPE + (size_t)T * 16 * 4;
constexpr size_t WS_BAR = WS_DPART + (size_t)4 * T * 4 * 4;
static_assert((size_t)4 * T * 1024 * 4 <= (size_t)T * D * 4 + (size_t)T * D * 2 + (size_t)T * D * 4, "MPART fits in YF | YB | TF");
constexpr size_t WS_CNT = WS_BAR + 16384;
constexpr size_t WS_ZERO_BYTES = 16384 + 4 * 32 * 256;
constexpr size_t WS_XBUF = WS_CNT + 4 * 32 * 256;
constexpr size_t WS_GPART = WS_XBUF + (size_t)4 * T * 8 * 8;
constexpr size_t WS_END = WS_GPART + (size_t)8 * T * 8 * 4;

struct Params { const float* in[23]; float* out; unsigned char* wsp; };
typedef const __attribute__((address_space(4))) Params* KP;
__device__ __forceinline__ KP kparams() { KP p = (KP)__builtin_amdgcn_kernarg_segment_ptr(); asm volatile("" : "+s"(p)); return p; }
#define KIN(i) (kparams()->in[i])
#define KWS (kparams()->wsp)

__device__ __forceinline__ unsigned pk2(float lo, float hi);
__device__ __forceinline__ unsigned f2bf(float f) { return pk2(f, 0.f) & 0xffffu; }
typedef float f32x2_t __attribute__((ext_vector_type(2)));
typedef __bf16 bf16x2_t __attribute__((ext_vector_type(2)));
__device__ __forceinline__ unsigned pk2(float lo, float hi) { f32x2_t v = {lo, hi}; bf16x2_t b = __builtin_convertvector(v, bf16x2_t); return __builtin_bit_cast(unsigned, b); }
__device__ __forceinline__ float bf2f(unsigned short b) { return __builtin_bit_cast(float, (unsigned)b << 16); }
__device__ __forceinline__ float bflo(unsigned w) { return __builtin_bit_cast(float, w << 16); }
__device__ __forceinline__ float bfhi(unsigned w) { return __builtin_bit_cast(float, w & 0xffff0000u); }
__device__ __forceinline__ float sigmoidf_(float x) { return __builtin_amdgcn_rcpf(1.0f + __expf(-x)); }
__device__ __forceinline__ float siluf_(float x) { return x * __builtin_amdgcn_rcpf(1.0f + __expf(-x)); }
__device__ __forceinline__ float wave_sum(float v) {
#pragma unroll
    for (int o = 1; o < 64; o <<= 1) v += __shfl_xor(v, o);
    return v;
}
__device__ __forceinline__ float sum16(float v) { v += __shfl_xor(v, 1); v += __shfl_xor(v, 2); v += __shfl_xor(v, 4); v += __shfl_xor(v, 8); return v; }
__device__ __forceinline__ float max16(float v) { v = fmaxf(v, __shfl_xor(v, 1)); v = fmaxf(v, __shfl_xor(v, 2)); v = fmaxf(v, __shfl_xor(v, 4)); v = fmaxf(v, __shfl_xor(v, 8)); return v; }
__device__ __forceinline__ int launder_i(int x) { asm volatile("" : "+v"(x)); return x; }
#define LBAR() do { asm volatile("s_waitcnt lgkmcnt(0)" ::: "memory"); __builtin_amdgcn_s_barrier(); asm volatile("" ::: "memory"); } while (0)
#define LDS_WAIT() asm volatile("s_waitcnt lgkmcnt(0)" ::: "memory")
__device__ __forceinline__ void unpack8(u32x4 w, float (&f)[8]) {
    f[0] = bflo(w.x); f[1] = bfhi(w.x); f[2] = bflo(w.y); f[3] = bfhi(w.y); f[4] = bflo(w.z); f[5] = bfhi(w.z); f[6] = bflo(w.w); f[7] = bfhi(w.w);
}
__device__ __forceinline__ bf16x8 frag(const LAS bf16_t* base, int ld, int tile, int ks, int lane) {
    return *(const LAS bf16x8*)(base + (tile * 16 + (lane & 15)) * ld + ks * 32 + (lane >> 4) * 8);
}
#define MFMA16(a, b, c) __builtin_amdgcn_mfma_f32_16x16x32_bf16((a), (b), (c), 0, 0, 0)

namespace pg8 {
constexpr int BM = 256, BK = 64, HALF = 128, HTB = HALF * BK * 2, STAGE_BYTES = 8 * HTB, NXCD = 8, WGM = 8;
__device__ __forceinline__ int lds_byte(int r, int c) { const int st = (r >> 4) * 2 + (c >> 5), rr = r & 15, cc = c & 31, ob = rr * 64 + cc * 2; return st * 1024 + (ob ^ (((ob >> 9) & 1) << 5)); }
__device__ __forceinline__ void stage_rc(int b, int& R, int& C) { const int st = b / 1024, sb = b % 1024, swz = sb ^ (((sb >> 9) & 1) << 5); R = (st >> 1) * 16 + swz / 64; C = (st & 1) * 32 + (swz % 64) / 2; }

struct Unit { int pm, pn, z; };
struct Sched {
    const char* A0; const char* B0; int strideA, strideB;
    int nM, nN, nwg, G, c, nz, K;
    __device__ __forceinline__ void init(int M, int N, int K_, int nz_, int G_, int c_) { nM = M / BM; nN = N / BM; nwg = nM * nN; G = G_; c = c_; nz = nz_; K = K_; }
    __device__ __forceinline__ bool next(int i, Unit& u) const {
        const int z = i % nz; const long L = (long)(i / nz) * G + c; if (L >= nwg) return false;
        int wgid = (int)L; { const int q = nwg / NXCD, r = nwg % NXCD, xcd = wgid % NXCD, off = wgid / NXCD; wgid = (xcd < r ? xcd * (q + 1) : r * (q + 1) + (xcd - r) * q) + off; }
        const int nig = WGM * nN, gid = wgid / nig, fm = gid * WGM, gsz = (nM - fm) < WGM ? (nM - fm) : WGM;
        u.pm = fm + ((wgid % nig) % gsz); u.pn = (wgid % nig) / gsz; u.z = z; return true;
    }
    __device__ __forceinline__ const char* abase(const Unit& u) const { return A0 + (size_t)u.z * strideA + (size_t)u.pm * (size_t)BM * K * 2; }
    __device__ __forceinline__ const char* bbase(const Unit& u) const { return B0 + (size_t)u.z * strideB + (size_t)u.pn * (size_t)BM * K * 2; }
};

template <class Epi>
__device__ __forceinline__ void gemm_phase(LAS unsigned char* lds, const Sched& S, const Epi& E) {
    const int tid = launder_i(threadIdx.x), wid = __builtin_amdgcn_readfirstlane(tid >> 6), lane = tid & 63, wr = wid >> 2, wc = wid & 3, fr = lane & 15, fq = lane >> 4;
    const int K = S.K, nt = K / BK;
    unsigned voffA[2], voffB[2];
#pragma unroll
    for (int i = 0; i < 2; ++i) { int R, C; stage_rc(tid * 16 + i * 8192, R, C); const int rho = R & 31, Rb = (R & ~31) + 8 * ((rho & 15) >> 2) + 4 * (rho >> 4) + (rho & 3);
        voffA[i] = (unsigned)(R * K + C) * 2u; voffB[i] = (unsigned)(Rb * K + C) * 2u; }
    const size_t kstep = (size_t)(BK * 2);
    const size_t hstep = (size_t)HALF * K * 2;
    const unsigned ldsw = (unsigned)wid * 1024u;
    const int aoff = lds_byte(wr * 64 + fr, fq * 8), boff = lds_byte(wc * 32 + fr, fq * 8);
#define PG8_SA(b, h) (((b) * 2 + (h)) * HTB)
#define PG8_SB(b, h) ((4 + (b) * 2 + (h)) * HTB)
#define PG8_STAGE2(bufoff, gbase, voff) do { _Pragma("unroll") for (int _i = 0; _i < 2; ++_i) \
        __builtin_amdgcn_global_load_lds((const unsigned*)((const char*)(gbase) + (voff)[_i]), (LAS unsigned*)(lds + (bufoff) + ldsw + _i * 8192), 16, 0, 0); } while (0)
#define PG8_LDA(dst, b, h) do { _Pragma("unroll") for (int m = 0; m < 4; ++m) _Pragma("unroll") for (int k = 0; k < 2; ++k) dst[m][k] = *(const LAS bf16x8*)(lds + PG8_SA(b, h) + aoff + m * 2048 + k * 1024); } while (0)
#define PG8_LDB(dst, b, h) do { _Pragma("unroll") for (int n = 0; n < 2; ++n) _Pragma("unroll") for (int k = 0; k < 2; ++k) dst[n][k] = *(const LAS bf16x8*)(lds + PG8_SB(b, h) + boff + n * 2048 + k * 1024); } while (0)
#define PG8_MMA(ai, bj, At, Bt) do { __builtin_amdgcn_s_setprio(1); _Pragma("unroll") for (int m = 0; m < 4; ++m) _Pragma("unroll") for (int n = 0; n < 2; ++n) _Pragma("unroll") for (int k = 0; k < 2; ++k) \
        acc[ai][bj][m][n] = __builtin_amdgcn_mfma_f32_16x16x32_bf16(Bt[n][k], At[m][k], acc[ai][bj][m][n], 0, 0, 0); __builtin_amdgcn_s_setprio(0); } while (0)
#define PG8_WAIT_V(n) asm volatile("s_waitcnt vmcnt(" #n ")" ::: "memory")
#define PG8_WAIT_L(n) asm volatile("s_waitcnt lgkmcnt(" #n ")" ::: "memory")
#define PG8_BAR __builtin_amdgcn_s_barrier()
#define PG8_SCHED __builtin_amdgcn_sched_barrier(0)
    Unit cur, nxt; int ui = 0;
    if (!S.next(0, cur)) return;
    f32x4 acc[2][2][4][2];
#pragma unroll
    for (int a = 0; a < 2; ++a)
#pragma unroll
        for (int b = 0; b < 2; ++b)
#pragma unroll
            for (int m = 0; m < 4; ++m)
#pragma unroll
                for (int n = 0; n < 2; ++n) acc[a][b][m][n] = (f32x4){0.f, 0.f, 0.f, 0.f};
    bf16x8 At[4][2], B0[2][2], B1[2][2];
    const char* cA = S.abase(cur); const char* cB = S.bbase(cur);
    PG8_STAGE2(PG8_SB(0, 0), cB, voffB); PG8_STAGE2(PG8_SB(0, 1), cB + hstep, voffB); PG8_STAGE2(PG8_SA(0, 0), cA, voffA); PG8_STAGE2(PG8_SA(0, 1), cA + hstep, voffA);
    if (wr == 1) PG8_BAR;
    PG8_WAIT_V(2); PG8_BAR;
    PG8_STAGE2(PG8_SB(1, 0), cB + kstep, voffB); PG8_STAGE2(PG8_SA(1, 0), cA + kstep, voffA); PG8_STAGE2(PG8_SB(1, 1), cB + hstep + kstep, voffB);
    PG8_WAIT_V(6); PG8_BAR;
    for (;;) {
        const bool has_next = S.next(ui + 1, nxt);
        const char* nA = has_next ? S.abase(nxt) : cA; const char* nB = has_next ? S.bbase(nxt) : cB;
        for (int t = 0; t < nt; t += 2) {
            const bool last = (t == nt - 2);
            const char* a1 = cA + (size_t)(t + 1) * kstep;
            const char* a2 = last ? nA : cA + (size_t)(t + 2) * kstep; const char* b2 = last ? nB : cB + (size_t)(t + 2) * kstep;
            const char* a3 = a2 + kstep; const char* b3 = b2 + kstep;
            PG8_LDB(B0, 0, 0); PG8_LDB(B1, 0, 1); PG8_SCHED; PG8_LDA(At, 0, 0); PG8_STAGE2(PG8_SA(1, 1), a1 + hstep, voffA);
            PG8_WAIT_V(8); PG8_WAIT_L(0); PG8_BAR; PG8_MMA(0, 0, At, B0); PG8_MMA(0, 1, At, B1); PG8_BAR; PG8_SCHED;
            PG8_LDA(At, 0, 1); PG8_STAGE2(PG8_SB(0, 0), b2, voffB); PG8_STAGE2(PG8_SB(0, 1), b2 + hstep, voffB); PG8_STAGE2(PG8_SA(0, 0), a2, voffA);
            PG8_WAIT_V(8); PG8_WAIT_L(0); PG8_BAR; PG8_MMA(1, 0, At, B0); PG8_MMA(1, 1, At, B1); PG8_BAR; PG8_SCHED;
            PG8_LDB(B0, 1, 0); PG8_LDB(B1, 1, 1); PG8_SCHED; PG8_LDA(At, 1, 0); PG8_STAGE2(PG8_SA(0, 1), a2 + hstep, voffA);
            PG8_WAIT_V(8); PG8_WAIT_L(0); PG8_BAR; PG8_MMA(0, 0, At, B0); PG8_MMA(0, 1, At, B1); PG8_BAR; PG8_SCHED;
            PG8_LDA(At, 1, 1); PG8_STAGE2(PG8_SB(1, 0), b3, voffB); PG8_STAGE2(PG8_SB(1, 1), b3 + hstep, voffB); PG8_STAGE2(PG8_SA(1, 0), a3, voffA);
            PG8_WAIT_V(8); PG8_WAIT_L(0); PG8_BAR; PG8_MMA(1, 0, At, B0); PG8_MMA(1, 1, At, B1); PG8_BAR; PG8_SCHED;
        }
        if (wr == 0) PG8_BAR;
        if constexpr (!Epi::AFTER_DRAIN) E(acc, cur, wr, wc, fr, fq);
        if (!has_next) break;
        if (!E.keep(cur))
#pragma unroll
        for (int a = 0; a < 2; ++a)
#pragma unroll
            for (int b = 0; b < 2; ++b)
#pragma unroll
                for (int m = 0; m < 4; ++m)
#pragma unroll
                    for (int n = 0; n < 2; ++n) acc[a][b][m][n] = (f32x4){0.f, 0.f, 0.f, 0.f};
        cur = nxt; cA = nA; cB = nB; ++ui;
        if (wr == 1) PG8_BAR;
    }
    PG8_WAIT_V(0);
    PG8_BAR;
    if constexpr (Epi::AFTER_DRAIN) E.fused(acc, cur, wr, wc, fr, fq, lds, wid, lane);
#undef PG8_SA
#undef PG8_SB
#undef PG8_STAGE2
#undef PG8_LDA
#undef PG8_LDB
#undef PG8_MMA
#undef PG8_WAIT_V
#undef PG8_WAIT_L
#undef PG8_BAR
#undef PG8_SCHED
}

struct EpiProj { static constexpr bool AFTER_DRAIN = false;
    bf16_t* O; const float* rope; int pn_off;
    __device__ __forceinline__ bool keep(const Unit&) const { return false; }
    __device__ __forceinline__ void operator()(const f32x4 (&acc)[2][2][4][2], const Unit& u, int wr, int wc, int fr, int fq) const {
        const int pn = u.pn + pn_off;
        const int row0 = u.pm * BM + wr * 64 + fr, col0 = pn * BM + wc * 32 + 8 * fq;
        const bool isrope = (pn >= 16 && pn < 24);
        const float qs = (pn >= 16 && pn < 20) ? 0.18033688011112042f : 1.0f;
#pragma unroll
        for (int ai = 0; ai < 2; ++ai)
#pragma unroll
            for (int m = 0; m < 4; ++m) {
                const int row = row0 + ai * HALF + m * 16;
                bf16_t* rowp = O + (size_t)row * NP + col0;
#pragma unroll
                for (int bj = 0; bj < 2; ++bj) {
                    f32x4 v0 = acc[ai][bj][m][0], v1 = acc[ai][bj][m][1];
                    if (isrope && ((wc & 1) == 0)) {
                        f32x4 p0, p1;
                        p0[0] = __shfl_xor(v0[0], 16); p0[1] = __shfl_xor(v0[1], 16); p0[2] = __shfl_xor(v0[2], 16); p0[3] = __shfl_xor(v0[3], 16);
                        p1[0] = __shfl_xor(v1[0], 16); p1[1] = __shfl_xor(v1[1], 16); p1[2] = __shfl_xor(v1[2], 16); p1[3] = __shfl_xor(v1[3], 16);
                        if (fq < 2) {
                            const f32x4 c0 = *(const f32x4*)(rope + (size_t)row * 16), c1 = *(const f32x4*)(rope + (size_t)row * 16 + 4);
                            const f32x4 s0 = *(const f32x4*)(rope + (size_t)row * 16 + 8), s1 = *(const f32x4*)(rope + (size_t)row * 16 + 12);
                            const float sg = (fq == 0) ? -1.0f : 1.0f;
                            v0 = v0 * c0 + (p0 * s0) * sg; v1 = v1 * c1 + (p1 * s1) * sg;
                        }
                    }
                    if (isrope) { v0 = v0 * qs; v1 = v1 * qs; }
                    u32x4 w; w.x = pk2(v0[0], v0[1]); w.y = pk2(v0[2], v0[3]); w.z = pk2(v1[0], v1[1]); w.w = pk2(v1[2], v1[3]);
                    *(u32x4*)(rowp + bj * HALF) = w;
                    asm volatile("" ::: "memory");
                }
            }
    }
};
struct EpiMerge { static constexpr bool AFTER_DRAIN = false;
    const bf16_t* proj; bf16_t* YB;
    __device__ __forceinline__ bool keep(const Unit& u) const { return u.z < 2; }
    static __device__ __forceinline__ float e1(float x) { return 1.0f + __expf(-fminf(fmaxf(x, -60.f), 60.f)); }
    __device__ __forceinline__ void operator()(f32x4 (&acc)[2][2][4][2], const Unit& u, int wr, int wc, int fr, int fq) const {
        const int row0 = u.pm * BM + wr * 64 + fr, col0 = u.pn * BM + wc * 32 + 8 * fq;
#pragma unroll
        for (int ai = 0; ai < 2; ++ai)
#pragma unroll
            for (int m = 0; m < 4; ++m) {
                const int row = row0 + ai * HALF + m * 16;
#pragma unroll
                for (int bj = 0; bj < 2; ++bj) {
                    const int col = col0 + bj * HALF;
                    const bf16_t* gp = proj + (size_t)row * NP + C_GATE + u.z * D + col;
                    const u32x4 ga = *(const u32x4*)gp;
                    float sc[8];
                    { float a[8]; unpack8(ga, a);
#pragma unroll
                      for (int j = 0; j < 8; ++j) sc[j] = __builtin_amdgcn_rcpf(e1(a[j])); }
                    if (u.z < 2) { const u32x4 gb = *(const u32x4*)(gp + D); float b[8]; unpack8(gb, b);
#pragma unroll
                      for (int j = 0; j < 8; ++j) sc[j] *= e1(b[j]); }
                    f32x4 v0 = acc[ai][bj][m][0], v1 = acc[ai][bj][m][1];
                    v0[0] *= sc[0]; v0[1] *= sc[1]; v0[2] *= sc[2]; v0[3] *= sc[3]; v1[0] *= sc[4]; v1[1] *= sc[5]; v1[2] *= sc[6]; v1[3] *= sc[7];
                    if (u.z < 2) { acc[ai][bj][m][0] = v0; acc[ai][bj][m][1] = v1; }
                    else { u32x4 w; w.x = pk2(v0[0], v0[1]); w.y = pk2(v0[2], v0[3]); w.z = pk2(v1[0], v1[1]); w.w = pk2(v1[2], v1[3]); *(u32x4*)(YB + (size_t)row * D + col) = w; }
                }
            }
    }
};
struct EpiResid { static constexpr bool AFTER_DRAIN = false;
    const bf16_t* H; bf16_t* TF;
    __device__ __forceinline__ bool keep(const Unit&) const { return false; }
    __device__ __forceinline__ void operator()(const f32x4 (&acc)[2][2][4][2], const Unit& u, int wr, int wc, int fr, int fq) const {
        const int row0 = u.pm * BM + wr * 64 + fr, col0 = u.pn * BM + wc * 32 + 8 * fq;
#pragma unroll
        for (int ai = 0; ai < 2; ++ai)
#pragma unroll
            for (int m = 0; m < 4; ++m) {
                const int row = row0 + ai * HALF + m * 16;
#pragma unroll
                for (int bj = 0; bj < 2; ++bj) {
                    const size_t o = (size_t)row * D + col0 + bj * HALF;
                    const u32x4 hb = *(const u32x4*)(H + o);
                    const f32x4 h0 = {bflo(hb.x), bfhi(hb.x), bflo(hb.y), bfhi(hb.y)}, h1 = {bflo(hb.z), bfhi(hb.z), bflo(hb.w), bfhi(hb.w)};
                    const f32x4 t0 = h0 * ALPHA + acc[ai][bj][m][0], t1 = h1 * ALPHA + acc[ai][bj][m][1];
                    u32x4 w; w.x = pk2(t0[0], t0[1]); w.y = pk2(t0[2], t0[3]); w.z = pk2(t1[0], t1[1]); w.w = pk2(t1[2], t1[3]);
                    *(u32x4*)(TF + o) = w;
                    asm volatile("" ::: "memory");
                }
            }
    }
};
struct EpiRelu2 { static constexpr bool AFTER_DRAIN = false;
    bf16_t* O;
    __device__ __forceinline__ bool keep(const Unit&) const { return false; }
    __device__ __forceinline__ void operator()(const f32x4 (&acc)[2][2][4][2], const Unit& u, int wr, int wc, int fr, int fq) const {
        const int row0 = u.pm * BM + wr * 64 + fr, col0 = u.pn * BM + wc * 32 + 8 * fq;
#pragma unroll
        for (int ai = 0; ai < 2; ++ai)
#pragma unroll
            for (int m = 0; m < 4; ++m) {
                bf16_t* rowp = O + (size_t)(row0 + ai * HALF + m * 16) * FF + col0;
#pragma unroll
                for (int bj = 0; bj < 2; ++bj) {
                    f32x4 v0 = acc[ai][bj][m][0], v1 = acc[ai][bj][m][1];
                    v0[0] = fmaxf(v0[0], 0.f); v0[1] = fmaxf(v0[1], 0.f); v0[2] = fmaxf(v0[2], 0.f); v0[3] = fmaxf(v0[3], 0.f);
                    v1[0] = fmaxf(v1[0], 0.f); v1[1] = fmaxf(v1[1], 0.f); v1[2] = fmaxf(v1[2], 0.f); v1[3] = fmaxf(v1[3], 0.f);
                    v0 = v0 * v0; v1 = v1 * v1;
                    u32x4 w; w.x = pk2(v0[0], v0[1]); w.y = pk2(v0[2], v0[3]); w.z = pk2(v1[0], v1[1]); w.w = pk2(v1[2], v1[3]);
                    *(u32x4*)(rowp + bj * HALF) = w;
                    asm volatile("" ::: "memory");
                }
            }
    }
};

struct PanelStats8 {
    unsigned long long* xbuf; unsigned* cnt; float eps;
    __device__ __forceinline__ void run(const f32x4 (&v)[2][2][4][2], const Unit& u, int wr, int wc, int fr, int fq, LAS unsigned char* lds, int wid, int lane) const {
        typedef float f32x2v __attribute__((ext_vector_type(2)));
        LAS f32x2v* Pt = (LAS f32x2v*)lds;
        LAS f32x2v* St = (LAS f32x2v*)(lds + 8192);
#pragma unroll
        for (int ai = 0; ai < 2; ++ai)
#pragma unroll
            for (int m = 0; m < 4; ++m) {
                float s = 0.f;
#pragma unroll
                for (int bj = 0; bj < 2; ++bj)
#pragma unroll
                    for (int n = 0; n < 2; ++n) { const f32x4 x = v[ai][bj][m][n]; s += (x[0] + x[1]) + (x[2] + x[3]); }
                s += __shfl_xor(s, 16); s += __shfl_xor(s, 32);
                const float mw = s * (1.0f / 64.0f); float q = 0.f;
#pragma unroll
                for (int bj = 0; bj < 2; ++bj)
#pragma unroll
                    for (int n = 0; n < 2; ++n) { const f32x4 d = v[ai][bj][m][n] - mw; q += (d[0] * d[0] + d[1] * d[1]) + (d[2] * d[2] + d[3] * d[3]); }
                q += __shfl_xor(q, 16); q += __shfl_xor(q, 32);
                if (fq == 0) Pt[(ai * HALF + wr * 64 + m * 16 + fr) * 4 + wc] = (f32x2v){mw, q};
            }
        asm volatile("s_waitcnt lgkmcnt(0)" ::: "memory"); __builtin_amdgcn_s_barrier(); asm volatile("" ::: "memory");
        const int row = wid * 32 + (lane & 31);
        if (lane < 32) {
            const f32x2v a = Pt[row * 4 + 0], b = Pt[row * 4 + 1], c = Pt[row * 4 + 2], d = Pt[row * 4 + 3];
            const float mt = (a.x + b.x + c.x + d.x) * 0.25f;
            const float da = a.x - mt, db = b.x - mt, dc = c.x - mt, dd = d.x - mt;
            const float m2 = (a.y + b.y) + (c.y + d.y) + 64.0f * ((da * da + db * db) + (dc * dc + dd * dd));
            unsigned long long* slot = xbuf + ((size_t)(u.pm * BM + row) * 8 + u.pn);
            __hip_atomic_store(slot, ((unsigned long long)__builtin_bit_cast(unsigned, m2) << 32) | __builtin_bit_cast(unsigned, mt), __ATOMIC_RELAXED, __HIP_MEMORY_SCOPE_AGENT);
        }
        asm volatile("s_waitcnt vmcnt(0)" ::: "memory");
        if (lane == 0) __hip_atomic_fetch_add(cnt + 64 * u.pm, 1u, __ATOMIC_RELAXED, __HIP_MEMORY_SCOPE_AGENT);
        if (wid == 0) {
            unsigned spins = 0;
            for (;;) {
                if ((unsigned)__builtin_amdgcn_readfirstlane(__hip_atomic_load(cnt + 64 * u.pm, __ATOMIC_RELAXED, __HIP_MEMORY_SCOPE_AGENT)) >= 64u) break;
                if (++spins > (1u << 22)) break;
            }
            __builtin_amdgcn_fence(__ATOMIC_ACQUIRE, "agent");
        }
        asm volatile("s_waitcnt vmcnt(0) lgkmcnt(0)" ::: "memory"); __builtin_amdgcn_s_barrier(); asm volatile("" ::: "memory");
        if (lane < 32) {
            const unsigned long long* slot = xbuf + (size_t)(u.pm * BM + row) * 8; float mt[8], m2[8]; float ms = 0.f;
#pragma unroll
            for (int t = 0; t < 8; ++t) { const unsigned long long w = __hip_atomic_load(slot + t, __ATOMIC_RELAXED, __HIP_MEMORY_SCOPE_AGENT); mt[t] = __builtin_bit_cast(float, (unsigned)w); m2[t] = __builtin_bit_cast(float, (unsigned)(w >> 32)); ms += mt[t]; }
            const float mean = ms * 0.125f; float q = 0.f;
#pragma unroll
            for (int t = 0; t < 8; ++t) { const float dm = mt[t] - mean; q += m2[t] + 256.0f * dm * dm; }
            St[row] = (f32x2v){mean, 1.0f / sqrtf(q * (1.0f / 2048.0f) + eps)};
        }
        asm volatile("s_waitcnt lgkmcnt(0)" ::: "memory"); __builtin_amdgcn_s_barrier(); asm volatile("" ::: "memory");
    }
};
template <bool OUT_F32, bool GATES>
struct EpiLn { static constexpr bool AFTER_DRAIN = true; static constexpr int DRAIN = 0;
    const bf16_t* H; const float* w; const float* b; bf16_t* outB; float* outF; PanelStats8 st;
    const float* win_next; const float* gbias; float* gpart;
    __device__ __forceinline__ bool keep(const Unit&) const { return false; }
    __device__ __forceinline__ void fused(f32x4 (&acc)[2][2][4][2], const Unit& u, int wr, int wc, int fr, int fq, LAS unsigned char* lds, int wid, int lane) const {
        typedef float f32x2v __attribute__((ext_vector_type(2)));
        const LAS f32x2v* St = (const LAS f32x2v*)(lds + 8192);
        const int col0 = u.pn * BM + wc * 32 + 8 * fq;
#pragma unroll
        for (int ai = 0; ai < 2; ++ai)
#pragma unroll
            for (int m = 0; m < 4; ++m) {
                const size_t ro = (size_t)(u.pm * BM + ai * HALF + wr * 64 + m * 16 + fr) * D + col0;
#pragma unroll
                for (int bj = 0; bj < 2; ++bj) {
                    const u32x4 hb = *(const u32x4*)(H + ro + bj * HALF);
                    const f32x4 h0 = {bflo(hb.x), bfhi(hb.x), bflo(hb.y), bfhi(hb.y)}, h1 = {bflo(hb.z), bfhi(hb.z), bflo(hb.w), bfhi(hb.w)};
                    acc[ai][bj][m][0] = h0 * ALPHA + acc[ai][bj][m][0]; acc[ai][bj][m][1] = h1 * ALPHA + acc[ai][bj][m][1];
                }
            }
        if (GATES) {
            LAS float* wgl = (LAS float*)(lds + 16384);
            const int tid_ = wid * 64 + lane;
            if (tid_ < 256) { const float* src = win_next + (size_t)(u.pn * BM + tid_) * NSRC + 4096; const f32x4 a = *(const f32x4*)src, c = *(const f32x4*)(src + 4);
                wgl[0 * 256 + tid_] = a[0]; wgl[1 * 256 + tid_] = a[1]; wgl[2 * 256 + tid_] = a[2]; wgl[3 * 256 + tid_] = a[3];
                wgl[4 * 256 + tid_] = c[0]; wgl[5 * 256 + tid_] = c[1]; wgl[6 * 256 + tid_] = c[2]; wgl[7 * 256 + tid_] = c[3]; }
        }
        st.run(acc, u, wr, wc, fr, fq, lds, wid, lane);
#pragma unroll
        for (int bj = 0; bj < 2; ++bj) {
            const f32x4 w0 = *(const f32x4*)(w + col0 + bj * HALF), w1 = *(const f32x4*)(w + col0 + bj * HALF + 4);
            const f32x4 b0 = *(const f32x4*)(b + col0 + bj * HALF), b1 = *(const f32x4*)(b + col0 + bj * HALF + 4);
#pragma unroll
            for (int ai = 0; ai < 2; ++ai)
#pragma unroll
                for (int m = 0; m < 4; ++m) {
                    const int r = ai * HALF + wr * 64 + m * 16 + fr; const f32x2v sr = St[r];
                    const size_t o = (size_t)(u.pm * BM + r) * D + col0 + bj * HALF;
                    const f32x4 o0 = ((acc[ai][bj][m][0] - sr.x) * sr.y) * w0 + b0, o1 = ((acc[ai][bj][m][1] - sr.x) * sr.y) * w1 + b1;
                    if (OUT_F32) { *(f32x4*)(outF + o) = o0; *(f32x4*)(outF + o + 4) = o1; }
                    else { u32x4 pw; pw.x = pk2(o0[0], o0[1]); pw.y = pk2(o0[2], o0[3]); pw.z = pk2(o1[0], o1[1]); pw.w = pk2(o1[2], o1[3]); *(u32x4*)(outB + o) = pw; }
                    if (GATES) { acc[ai][bj][m][0] = o0; acc[ai][bj][m][1] = o1; }
                }
        }
        if (GATES) {
            const LAS float* wgl = (const LAS float*)(lds + 16384);
            LAS float* GP = (LAS float*)(lds + 32768);
#pragma unroll 1
            for (int g = 0; g < 8; ++g) {
                const LAS float* wq = wgl + g * 256 + wc * 32 + 8 * fq;
                const f32x4 q00 = *(const LAS f32x4*)(wq), q01 = *(const LAS f32x4*)(wq + 4), q10 = *(const LAS f32x4*)(wq + HALF), q11 = *(const LAS f32x4*)(wq + HALF + 4);
#pragma unroll
                for (int ai = 0; ai < 2; ++ai)
#pragma unroll
                    for (int m = 0; m < 4; ++m) {
                        const f32x4 a0 = acc[ai][0][m][0] * q00 + acc[ai][0][m][1] * q01 + acc[ai][1][m][0] * q10 + acc[ai][1][m][1] * q11;
                        float p = (a0[0] + a0[1]) + (a0[2] + a0[3]);
                        p += __shfl_xor(p, 16); p += __shfl_xor(p, 32);
                        if (fq == 0) GP[((ai * HALF + wr * 64 + m * 16 + fr) * 8 + g) * 4 + wc] = p;
                    }
            }
            asm volatile("s_waitcnt lgkmcnt(0)" ::: "memory"); __builtin_amdgcn_s_barrier(); asm volatile("" ::: "memory");
            const int tid_ = wid * 64 + lane;
#pragma unroll
            for (int i = 0; i < 4; ++i) {
                const int idx = tid_ + 512 * i, row = idx >> 3, g = idx & 7;
                const f32x4 pp = *(const LAS f32x4*)(GP + idx * 4);
                float v = (pp[0] + pp[1]) + (pp[2] + pp[3]);
                if (u.pn == 0) v += gbias[g];
                gpart[(size_t)u.pn * T * 8 + (size_t)(u.pm * BM + row) * 8 + g] = v;
            }
        }
    }
};
}

__device__ __forceinline__ void tr_item(const float* W, int ldw, int src_c0, bf16_t* WT, int K, int n0, int k0, LAS float* scr, int lane) {
    const int r4 = lane >> 4, c4 = (lane & 15) * 4;
#pragma unroll 8
    for (int it = 0; it < 16; ++it) { const int kk = 4 * it + r4; const f32x4 v = __builtin_nontemporal_load((const f32x4*)(W + (size_t)(k0 + kk) * ldw + src_c0 + c4));
        LAS float* d = scr + kk * 65 + c4; d[0] = v[0]; d[1] = v[1]; d[2] = v[2]; d[3] = v[3]; }
    LDS_WAIT();
    const int c = lane & 7;
#pragma unroll
    for (int j = 0; j < 8; ++j) { const int n = (lane >> 3) + 8 * j; const LAS float* s = scr + (8 * c) * 65 + n;
        u32x4 o; o.x = pk2(s[0 * 65], s[1 * 65]); o.y = pk2(s[2 * 65], s[3 * 65]); o.z = pk2(s[4 * 65], s[5 * 65]); o.w = pk2(s[6 * 65], s[7 * 65]);
        *(u32x4*)(WT + (size_t)(n0 + n) * K + k0 + 8 * c) = o; }
    LDS_WAIT();
}
__device__ __forceinline__ void tr_matrix_item(const float* W, int K, int N, int ldw, bool skip8, bf16_t* WT, int item, LAS float* scr, int lane) {
    const int nblk = N / 64, kb = item / nblk, nb = item % nblk, n0 = nb * 64;
    const int src = n0 + ((skip8 && n0 >= 4096) ? 8 : 0);
    tr_item(W, ldw, src, WT, K, n0, kb * 64, scr, lane);
}

template <bool GATES, bool WRITE_B, bool WRITE_F, bool SRC_BF16>
__device__ __forceinline__ void ln_phase(const float* src, const float* w, const float* b, float* dstF, bf16_t* dstB,
                                         const float* win_l  , const float* gate_b, float* gif, LAS unsigned char* lds, int G) {
    const int tid = launder_i(threadIdx.x), lane = tid & 63, wid = tid >> 6;
    LAS float* wg = (LAS float*)lds;
    if (GATES) {
        for (int k = tid; k < D; k += NTHREADS) {
            const f32x4 a = *(const f32x4*)(win_l + (size_t)k * NSRC + 4096), c = *(const f32x4*)(win_l + (size_t)k * NSRC + 4100);
            wg[0 * D + k] = a[0]; wg[1 * D + k] = a[1]; wg[2 * D + k] = a[2]; wg[3 * D + k] = a[3];
            wg[4 * D + k] = c[0]; wg[5 * D + k] = c[1]; wg[6 * D + k] = c[2]; wg[7 * D + k] = c[3];
        }
        __syncthreads();
    }
    const int rstep = G * NWAVES, row_first = blockIdx.x * NWAVES + wid;
    u32x2 rawb[8]; f32x4 rawf[8];
    if (row_first < T) {
#pragma unroll
        for (int j = 0; j < 8; ++j) { if (SRC_BF16) rawb[j] = *(const u32x2*)((const bf16_t*)src + (size_t)row_first * D + 256 * j + 4 * lane); else rawf[j] = *(const f32x4*)(src + (size_t)row_first * D + 256 * j + 4 * lane); }
    }
    for (int row = row_first; row < T; row += rstep) {
        f32x4 v[8]; float s = 0.f;
#pragma unroll
        for (int j = 0; j < 8; ++j) {
            if (SRC_BF16) v[j] = (f32x4){bflo(rawb[j].x), bfhi(rawb[j].x), bflo(rawb[j].y), bfhi(rawb[j].y)}; else v[j] = rawf[j];
            s += (v[j][0] + v[j][1]) + (v[j][2] + v[j][3]);
        }
        if (row + rstep < T) {
#pragma unroll
            for (int j = 0; j < 8; ++j) { if (SRC_BF16) rawb[j] = *(const u32x2*)((const bf16_t*)src + (size_t)(row + rstep) * D + 256 * j + 4 * lane); else rawf[j] = *(const f32x4*)(src + (size_t)(row + rstep) * D + 256 * j + 4 * lane); }
        }
        const float mean = wave_sum(s) * (1.0f / D); float s2 = 0.f;
#pragma unroll
        for (int j = 0; j < 8; ++j) { v[j] = v[j] - mean; s2 += (v[j][0] * v[j][0] + v[j][1] * v[j][1]) + (v[j][2] * v[j][2] + v[j][3] * v[j][3]); }
        const float rstd = 1.0f / sqrtf(wave_sum(s2) * (1.0f / D) + LN_EPS);
#pragma unroll
        for (int j = 0; j < 8; ++j) {
            const f32x4 wvj = *(const f32x4*)(w + 256 * j + 4 * lane), bvj = *(const f32x4*)(b + 256 * j + 4 * lane);
            v[j] = (v[j] * rstd) * wvj + bvj;
            if (WRITE_F) *(f32x4*)(dstF + (size_t)row * D + 256 * j + 4 * lane) = v[j];
            if (WRITE_B) { u32x2 o; o.x = pk2(v[j][0], v[j][1]); o.y = pk2(v[j][2], v[j][3]); *(u32x2*)(dstB + (size_t)row * D + 256 * j + 4 * lane) = o; }
        }
        if (GATES) {
            float mine = 0.f;
#pragma unroll 1
            for (int g = 0; g < 8; ++g) {
                float p = 0.f;
#pragma unroll
                for (int j = 0; j < 8; ++j) { const f32x4 q = *(const LAS f32x4*)(wg + g * D + 256 * j + 4 * lane); p += (v[j][0] * q[0] + v[j][1] * q[1]) + (v[j][2] * q[2] + v[j][3] * q[3]); }
                p = wave_sum(p);
                if (lane == g) mine = p + gate_b[g];
            }
            if (lane < 8) gif[(size_t)row * 8 + lane] = mine;
        }
    }
    if (GATES) __syncthreads();
}

typedef short v4i16_t __attribute__((ext_vector_type(4)));
__device__ __forceinline__ bf16x8 trfrag2(const LAS bf16_t* p0, const LAS bf16_t* p1) {
    const v4i16_t a = __builtin_amdgcn_ds_read_tr16_b64_v4i16((LAS v4i16_t*)p0), b = __builtin_amdgcn_ds_read_tr16_b64_v4i16((LAS v4i16_t*)p1);
    bf16x8 r; r[0] = a[0]; r[1] = a[1]; r[2] = a[2]; r[3] = a[3]; r[4] = b[0]; r[5] = b[1]; r[6] = b[2]; r[7] = b[3]; return r;
}
__device__ __forceinline__ bf16x8 trfrag(const LAS bf16_t* base, int ld, int row0, int col0, int lane) {
    const int g = lane >> 4, q = (lane & 15) >> 2, p = lane & 3;
    const LAS bf16_t* p0 = base + (row0 + 8 * g + q) * ld + col0 + 4 * p;
    return trfrag2(p0, p0 + 4 * ld);
}

__device__ __forceinline__ void mlstm_unit(int unit, int l, const bf16_t* proj, const float* gif, const float* conv_w, const float* conv_b, bf16_t* mpart, float* dpart, int gplanes, LAS unsigned char* lds) {
    const int tid = launder_i(threadIdx.x), lane = tid & 63, wid = __builtin_amdgcn_readfirstlane(tid >> 6);
    const int b = unit >> 4, h = (unit >> 2) & 3, dq = unit & 3;
    const int g = lane >> 4, c16 = lane & 15;
    LAS bf16_t* Q = (LAS bf16_t*)(lds);
    LAS bf16_t* KK = (LAS bf16_t*)(lds + 9216);
    LAS bf16_t* V1 = (LAS bf16_t*)(lds + 18432);
    LAS bf16_t* VW = (LAS bf16_t*)(lds + 52224);
    LAS bf16_t* ST = (LAS bf16_t*)(lds + 86016);
    LAS bf16_t* AS = (LAS bf16_t*)(lds + 122880);
    LAS float* CWL = (LAS float*)(lds + 132096);
    LAS float* tabs = (LAS float*)(lds + 134656);
    LAS float* nvec = tabs + 384;
    LAS float* dsum = nvec + 64;
    LAS float* qn = dsum + 128;
    LAS float* npart = qn + 64;
    for (int i = tid; i < 256 * 72 / 2; i += NTHREADS) ((LAS unsigned*)ST)[i] = 0u;
    if (tid < 64) nvec[tid] = 0.f;
    if (tid < 128) {
        const float* cw = conv_w + (size_t)l * 4 * 2048; const float* cb = conv_b + (size_t)l * 2048;
        const int gcol = (tid >> 6) * 1024 + h * 256 + dq * 64 + (tid & 63);
#pragma unroll
        for (int tap = 0; tap < 4; ++tap) CWL[tap * 128 + tid] = cw[tap * 2048 + gcol];
        CWL[4 * 128 + tid] = cb[gcol];
    }
    f32x4 ct[2][4];
#pragma unroll
    for (int a = 0; a < 2; ++a)
#pragma unroll
        for (int n = 0; n < 4; ++n) ct[a][n] = (f32x4){0.f, 0.f, 0.f, 0.f};
    const int dgi = tid & 15, run = tid >> 4, lcol = (dgi >> 3) * 1024 + h * 256 + dq * 64 + (dgi & 7) * 8;
    const bf16_t* pq = proj + ((size_t)b * SEQ + run * 2 - 3) * NP + lcol;
    const bf16_t* pv = proj + ((size_t)b * SEQ + (tid >> 3)) * NP + C_MV + h * 256 + (tid & 7) * 8;
    const float* pg = gif + ((size_t)b * SEQ + lane) * 8 + h;
    u32x4 pf[5], pfv[4]; float pfi = 0.f, pff = 0.f; float pgi7[7] = {0.f, 0.f, 0.f, 0.f, 0.f, 0.f, 0.f}, pgf7[7] = {0.f, 0.f, 0.f, 0.f, 0.f, 0.f, 0.f};
#pragma unroll
    for (int i = 0; i < 5; ++i) { if (run * 2 - 3 + i < 0) pf[i] = (u32x4){0u, 0u, 0u, 0u}; else pf[i] = *(const u32x4*)(pq + (size_t)i * NP); }
#pragma unroll
    for (int i = 0; i < 4; ++i) pfv[i] = *(const u32x4*)(pv + 64 * i);
    if (wid == 0) {
        float ipre = pg[0], fpre = pg[4];
        if (gplanes == 8) {
            float gi_[7], gf_[7];
#pragma unroll
            for (int gp = 0; gp < 7; ++gp) { gi_[gp] = pg[(size_t)(gp + 1) * T * 8]; gf_[gp] = pg[(size_t)(gp + 1) * T * 8 + 4]; }
#pragma unroll
            for (int gp = 0; gp < 7; ++gp) { ipre += gi_[gp]; fpre += gf_[gp]; }
        }
        float v = fminf(fpre, 0.f) - __logf(1.0f + __expf(-fabsf(fpre)));
#pragma unroll
        for (int off = 1; off < 64; off <<= 1) { const float tv = __shfl_up(v, off); if (lane >= off) v += tv; }
        const float Gc = __shfl(v, 63);
        tabs[lane] = v; tabs[64 + lane] = ipre; tabs[128 + lane] = __expf(Gc - v + ipre) * 0.0625f;
    }
    __syncthreads();
    for (int c = 0; c < SEQ / 64; ++c) {
        const int t0 = c * 64; const size_t rowbase = (size_t)b * SEQ + t0;
        const LAS float* bcum = tabs + (c & 1) * 192; const LAS float* ig = bcum + 64; const LAS float* wsc = bcum + 128;
        const float Gc = bcum[63];
        {
            float cwr[5][8];
#pragma unroll
            for (int tap = 0; tap < 5; ++tap) { const f32x4 a = *(const LAS f32x4*)(CWL + tap * 128 + dgi * 8), c2 = *(const LAS f32x4*)(CWL + tap * 128 + dgi * 8 + 4);
                cwr[tap][0] = a[0]; cwr[tap][1] = a[1]; cwr[tap][2] = a[2]; cwr[tap][3] = a[3]; cwr[tap][4] = c2[0]; cwr[tap][5] = c2[1]; cwr[tap][6] = c2[2]; cwr[tap][7] = c2[3]; }
            LAS bf16_t* dst = ((dgi >> 3) ? KK : Q) + (run * 2) * 72 + (dgi & 7) * 8;
#pragma unroll
            for (int i = 0; i < 2; ++i) {
                float a[8];
#pragma unroll
                for (int j = 0; j < 8; ++j) a[j] = cwr[4][j];
#pragma unroll
                for (int tap = 0; tap < 4; ++tap) { float xf[8]; unpack8(pf[i + tap], xf);
#pragma unroll
                    for (int j = 0; j < 8; ++j) a[j] += cwr[tap][j] * xf[j]; }
#pragma unroll
                for (int j = 0; j < 8; ++j) a[j] = siluf_(a[j]);
                u32x4 o; o.x = pk2(a[0], a[1]); o.y = pk2(a[2], a[3]); o.z = pk2(a[4], a[5]); o.w = pk2(a[6], a[7]);
                *(LAS u32x4*)(dst + i * 72) = o;
            }
            if (c > 0 && tid < 64) {
                float sn = 0.f;
#pragma unroll
                for (int w8 = 0; w8 < 8; ++w8) sn += npart[w8 * 64 + tid];
                nvec[tid] = __expf(tabs[((c - 1) & 1) * 192 + 63]) * nvec[tid] + sn;
            }
            const int tv = tid >> 3, eg = tid & 7; const float w = wsc[tv];
#pragma unroll
            for (int i = 0; i < 4; ++i) {
                *(LAS u32x4*)(V1 + tv * 264 + (eg + 8 * i) * 8) = pfv[i];
                float vf[8]; unpack8(pfv[i], vf);
                u32x4 o; o.x = pk2(vf[0] * w, vf[1] * w); o.y = pk2(vf[2] * w, vf[3] * w); o.z = pk2(vf[4] * w, vf[5] * w); o.w = pk2(vf[6] * w, vf[7] * w);
                *(LAS u32x4*)(VW + tv * 264 + (eg + 8 * i) * 8) = o;
            }
        }
        LBAR();
        if (c + 1 < SEQ / 64) {
            pq += (size_t)64 * NP; pv += (size_t)64 * NP; pg += 64 * 8;
#pragma unroll
            for (int i = 0; i < 5; ++i) pf[i] = *(const u32x4*)(pq + (size_t)i * NP);
#pragma unroll
            for (int i = 0; i < 4; ++i) pfv[i] = *(const u32x4*)(pv + 64 * i);
            if (wid == 0) { pfi = pg[0]; pff = pg[4];
                if (gplanes == 8) {
#pragma unroll
                    for (int gp = 0; gp < 7; ++gp) { pgi7[gp] = pg[(size_t)(gp + 1) * T * 8]; pgf7[gp] = pg[(size_t)(gp + 1) * T * 8 + 4]; }
                } }
        }
        {
            const int mt = wid >> 1, nt0 = (wid & 1) * 2;
            f32x4 s0 = {0.f, 0.f, 0.f, 0.f}, s1 = {0.f, 0.f, 0.f, 0.f};
#pragma unroll
            for (int ks = 0; ks < 2; ++ks) { const bf16x8 a = frag(Q, 72, mt, ks, lane); s0 = MFMA16(a, frag(KK, 72, nt0, ks, lane), s0); s1 = MFMA16(a, frag(KK, 72, nt0 + 1, ks, lane), s1); }
            float rs[4];
#pragma unroll
            for (int j = 0; j < 4; ++j) {
                const int t = 16 * mt + 4 * g + j; const float bt = bcum[t];
                const int sa = 16 * nt0 + c16, sb = sa + 16;
                const float va = (sa <= t) ? s0[j] * __expf(bt - bcum[sa] + ig[sa]) * 0.0625f : 0.f;
                const float vb = (sb <= t) ? s1[j] * __expf(bt - bcum[sb] + ig[sb]) * 0.0625f : 0.f;
                AS[t * 72 + sa] = (bf16_t)f2bf(va); AS[t * 72 + sb] = (bf16_t)f2bf(vb);
                rs[j] = sum16(va + vb);
            }
            if (c16 == 0) {
#pragma unroll
                for (int j = 0; j < 4; ++j) dsum[(wid & 1) * 64 + 16 * mt + 4 * g + j] = rs[j];
            }
            const int t = tid >> 3, part = tid & 7; float p = 0.f;
            { const u32x4 qv = *(const LAS u32x4*)(Q + t * 72 + part * 8); float qf[8]; unpack8(qv, qf);
#pragma unroll
              for (int j = 0; j < 8; ++j) p += qf[j] * nvec[part * 8 + j]; }
            p += __shfl_xor(p, 1); p += __shfl_xor(p, 2); p += __shfl_xor(p, 4);
            if (part == 0) qn[t] = p;
        }
        LBAR();
        {
            f32x4 o1[2][4], o2[2][4];
#pragma unroll
            for (int ei = 0; ei < 2; ++ei)
#pragma unroll
                for (int tt = 0; tt < 4; ++tt) { o1[ei][tt] = (f32x4){0.f, 0.f, 0.f, 0.f}; o2[ei][tt] = (f32x4){0.f, 0.f, 0.f, 0.f}; }
#pragma unroll
            for (int ks = 0; ks < 2; ++ks) {
                const bf16x8 av0 = trfrag(V1, 264, 32 * ks, 16 * (2 * wid), lane), av1 = trfrag(V1, 264, 32 * ks, 16 * (2 * wid + 1), lane);
                const bf16x8 as0 = frag(ST, 72, 2 * wid, ks, lane), as1 = frag(ST, 72, 2 * wid + 1, ks, lane);
#pragma unroll
                for (int tt = 0; tt < 4; ++tt) {
                    const bf16x8 ba = frag(AS, 72, tt, ks, lane), bq = frag(Q, 72, tt, ks, lane);
                    o1[0][tt] = MFMA16(av0, ba, o1[0][tt]); o1[1][tt] = MFMA16(av1, ba, o1[1][tt]);
                    o2[0][tt] = MFMA16(as0, bq, o2[0][tt]); o2[1][tt] = MFMA16(as1, bq, o2[1][tt]);
                }
            }
#pragma unroll
            for (int tt = 0; tt < 4; ++tt) {
                const int t = 16 * tt + c16; const float wI = __expf(bcum[t]);
                bf16_t* orow = mpart + (rowbase + t) * 1024 + h * 256 + 32 * wid + 4 * g;
                const f32x4 r0 = o1[0][tt] + o2[0][tt] * wI, r1 = o1[1][tt] + o2[1][tt] * wI;
                u32x2 w0, w1; w0.x = pk2(r0[0], r0[1]); w0.y = pk2(r0[2], r0[3]); w1.x = pk2(r1[0], r1[1]); w1.y = pk2(r1[2], r1[3]);
                *(u32x2*)(orow) = w0; *(u32x2*)(orow + 16) = w1;
            }
            if (tid < 64) dpart[(rowbase + tid) * 4 + h] = dsum[tid] + dsum[64 + tid] + __expf(bcum[tid]) * qn[tid];
        }
        {
            const float dec = __expf(Gc);
#pragma unroll
            for (int a = 0; a < 2; ++a)
#pragma unroll
                for (int n = 0; n < 4; ++n) ct[a][n] = ct[a][n] * dec;
#pragma unroll
            for (int ks = 0; ks < 2; ++ks) {
                const bf16x8 a0 = trfrag(VW, 264, 32 * ks, 16 * (2 * wid), lane), a1 = trfrag(VW, 264, 32 * ks, 16 * (2 * wid + 1), lane);
#pragma unroll
                for (int n = 0; n < 4; ++n) { const bf16x8 bk = trfrag(KK, 72, 32 * ks, 16 * n, lane); ct[0][n] = MFMA16(a0, bk, ct[0][n]); ct[1][n] = MFMA16(a1, bk, ct[1][n]); }
            }
#pragma unroll
            for (int a = 0; a < 2; ++a)
#pragma unroll
                for (int n = 0; n < 4; ++n)
#pragma unroll
                    for (int j = 0; j < 4; ++j) ST[(16 * (2 * wid + a) + 4 * g + j) * 72 + 16 * n + c16] = (bf16_t)f2bf(ct[a][n][j]);
            {
                float sn = 0.f;
#pragma unroll
                for (int i = 0; i < 8; ++i) sn += wsc[wid * 8 + i] * bf2f(KK[(wid * 8 + i) * 72 + lane]);
                npart[wid * 64 + lane] = sn;
            }
            if (wid == 0 && c + 1 < SEQ / 64) {
                LAS float* nb = tabs + ((c + 1) & 1) * 192;
#pragma unroll
                for (int gp = 0; gp < 7; ++gp) { pfi += pgi7[gp]; pff += pgf7[gp]; }
                float v = fminf(pff, 0.f) - __logf(1.0f + __expf(-fabsf(pff)));
#pragma unroll
                for (int off = 1; off < 64; off <<= 1) { const float tv = __shfl_up(v, off); if (lane >= off) v += tv; }
                const float Gn = __shfl(v, 63);
                nb[lane] = v; nb[64 + lane] = pfi; nb[128 + lane] = __expf(Gn - v + pfi) * 0.0625f;
            }
        }
        LBAR();
    }
}

__device__ __forceinline__ void hgrn_unit(int unit, int l, const bf16_t* proj, const float* lb_logits, bf16_t* hpart, LAS unsigned char* lds) {
    const int tid = launder_i(threadIdx.x), lane = tid & 63, wid = __builtin_amdgcn_readfirstlane(tid >> 6);
    const int b = unit >> 4, h = (unit >> 1) & 7, kh = unit & 1;
    const int g = lane >> 4, c16 = lane & 15;
    LAS bf16_t* QA = (LAS bf16_t*)(lds);
    LAS bf16_t* KA = (LAS bf16_t*)(lds + 4608);
    LAS bf16_t* KB = (LAS bf16_t*)(lds + 9216);
    LAS bf16_t* VV = (LAS bf16_t*)(lds + 13824);
    LAS bf16_t* AS = (LAS bf16_t*)(lds + 22528);
    LAS bf16_t* ST = (LAS bf16_t*)(lds + 25088);
    LAS float* GD = (LAS float*)(lds + 43520);
    for (int i = tid; i < 128 * 72 / 2; i += NTHREADS) ((LAS unsigned*)ST)[i] = 0u;
    f32x4 st[4];
#pragma unroll
    for (int n = 0; n < 4; ++n) st[n] = (f32x4){0.f, 0.f, 0.f, 0.f};
    const int t = lane & 31, kg = tid >> 5;
    float lbv[4];
#pragma unroll
    for (int j = 0; j < 4; ++j) {
        const int ch = h * 128 + kh * 64 + kg * 4 + j;
        lbv[j] = (l == 0) ? 0.f : 1.0f / (1.0f + expf(lb_logits[ch] - lb_logits[1024 + ch]));
    }
    const bf16_t* pb = proj + ((size_t)b * SEQ + t) * NP + h * 128;
    u32x2 pgf = *(const u32x2*)(pb + C_GF + kh * 64 + kg * 4), pgq = *(const u32x2*)(pb + C_GQ + kh * 64 + kg * 4); u32x4 pgi = *(const u32x4*)(pb + C_GI + kg * 8);
    __syncthreads();
    for (int c = 0; c < SEQ / 32; ++c) {
        {
            float gf[4] = {bflo(pgf.x), bfhi(pgf.x), bflo(pgf.y), bfhi(pgf.y)}, qf[4] = {bflo(pgq.x), bfhi(pgq.x), bflo(pgq.y), bfhi(pgq.y)};
            float lf[4], kk[4], qa[4], ka[4], kb[4];
#pragma unroll
            for (int j = 0; j < 4; ++j) { const float f = lbv[j] + (1.0f - lbv[j]) * sigmoidf_(gf[j]); lf[j] = __logf(fmaxf(f, 1e-30f)); kk[j] = 1.0f - f; }
#pragma unroll
            for (int off = 1; off < 32; off <<= 1)
#pragma unroll
                for (int j = 0; j < 4; ++j) { const float v = __shfl_up(lf[j], off, 32); if (t >= off) lf[j] += v; }
#pragma unroll
            for (int j = 0; j < 4; ++j) {
                const float Gk = __shfl(lf[j], 31, 32);
                qa[j] = siluf_(qf[j]) * __expf(lf[j]); ka[j] = kk[j] * __expf(fminf(-lf[j], 80.f)); kb[j] = kk[j] * __expf(Gk - lf[j]);
                if (t == 31) GD[kg * 4 + j] = __expf(Gk);
            }
            u32x2 o; o.x = pk2(qa[0], qa[1]); o.y = pk2(qa[2], qa[3]); *(LAS u32x2*)(QA + t * 72 + kg * 4) = o;
            o.x = pk2(ka[0], ka[1]); o.y = pk2(ka[2], ka[3]); *(LAS u32x2*)(KA + t * 72 + kg * 4) = o;
            o.x = pk2(kb[0], kb[1]); o.y = pk2(kb[2], kb[3]); *(LAS u32x2*)(KB + t * 72 + kg * 4) = o;
            *(LAS u32x4*)(VV + t * 136 + kg * 8) = pgi;
        }
        LBAR();
        if (c + 1 < SEQ / 32) { pb += (size_t)32 * NP; pgf = *(const u32x2*)(pb + C_GF + kh * 64 + kg * 4); pgq = *(const u32x2*)(pb + C_GQ + kh * 64 + kg * 4); pgi = *(const u32x4*)(pb + C_GI + kg * 8); }
        if (wid < 4) {
            const int mt = wid >> 1, nt = wid & 1; f32x4 s = {0.f, 0.f, 0.f, 0.f};
#pragma unroll
            for (int ks = 0; ks < 2; ++ks) s = MFMA16(frag(QA, 72, mt, ks, lane), frag(KA, 72, nt, ks, lane), s);
#pragma unroll
            for (int j = 0; j < 4; ++j) { const int tt = 16 * mt + 4 * g + j, ss = 16 * nt + c16; AS[tt * 40 + ss] = (bf16_t)f2bf(ss <= tt ? s[j] : 0.f); }
        }
        LBAR();
        const bf16x8 vfr = trfrag(VV, 136, 0, 16 * wid, lane);
        {
#pragma unroll
            for (int mt = 0; mt < 2; ++mt) {
                f32x4 a = {0.f, 0.f, 0.f, 0.f};
                a = MFMA16(vfr, frag(AS, 40, mt, 0, lane), a);
#pragma unroll
                for (int ks = 0; ks < 2; ++ks) a = MFMA16(frag(ST, 72, wid, ks, lane), frag(QA, 72, mt, ks, lane), a);
                { u32x2 w; w.x = pk2(a[0], a[1]); w.y = pk2(a[2], a[3]); *(u32x2*)(hpart + ((size_t)b * SEQ + c * 32 + 16 * mt + c16) * 1024 + h * 128 + 16 * wid + 4 * g) = w; }
            }
        }
        {
#pragma unroll
            for (int n = 0; n < 4; ++n) {
                const float dec = GD[16 * n + c16];
                st[n] = st[n] * dec;
                st[n] = MFMA16(vfr, trfrag(KB, 72, 0, 16 * n, lane), st[n]);
#pragma unroll
                for (int j = 0; j < 4; ++j) ST[(16 * wid + 4 * g + j) * 72 + 16 * n + c16] = (bf16_t)f2bf(st[n][j]);
            }
        }
        LBAR();
    }
}

__device__ __forceinline__ void attn_unit(int u, int l, const bf16_t* proj, const float* a_lambda, const float* a_norm_w, bf16_t* ha, LAS unsigned char* lds) {
    const int tid = launder_i(threadIdx.x), lane = tid & 63, wid = __builtin_amdgcn_readfirstlane(tid >> 6);
    const int a_ = u & 127, i_ = u >> 7, j_ = a_ >> 5, bh = a_ & 31;
    const int qb = (i_ == 0) ? 15 - j_ : ((i_ == 1) ? j_ : ((i_ == 2) ? 11 - j_ : 4 + j_)), b = bh >> 3, h = bh & 7, q0 = qb * 128;
    const int g = lane >> 4, c16 = lane & 15;
    const float lam_init = 0.8f - 0.6f * expf(-0.3f * (float)l);
    float lam;
    { const float* lv = a_lambda + (size_t)l * 256; const float s1 = wave_sum(lv[lane] * lv[64 + lane]), s2 = wave_sum(lv[128 + lane] * lv[192 + lane]); lam = expf(s1) - expf(s2) + lam_init; }
    const int qrow = q0 + 16 * wid + c16;
    bf16x8 qf[2][2];
#pragma unroll
    for (int n = 0; n < 2; ++n)
#pragma unroll
        for (int ks = 0; ks < 2; ++ks) qf[n][ks] = *(const bf16x8*)(proj + ((size_t)b * SEQ + qrow) * NP + C_AQ + h * 128 + n * 64 + ks * 32 + g * 8);
    float mrow[2] = {-1e30f, -1e30f}, lrow[2] = {0.f, 0.f}; f32x4 O[2][8];
#pragma unroll
    for (int n = 0; n < 2; ++n)
#pragma unroll
        for (int e = 0; e < 8; ++e) O[n][e] = (f32x4){0.f, 0.f, 0.f, 0.f};
    const int ntiles = 2 * qb + 2;
    const int lr = tid >> 4, lc = (tid & 15) * 8;
    const bf16_t* pk = proj + ((size_t)b * SEQ + lr) * NP + C_AK + h * 128 + lc;
    const bf16_t* pvv = proj + ((size_t)b * SEQ + lr) * NP + C_AV + h * 128 + lc;
    u32x4 rk0 = *(const u32x4*)pk, rk1 = *(const u32x4*)(pk + (size_t)32 * NP), rv0 = *(const u32x4*)pvv, rv1 = *(const u32x4*)(pvv + (size_t)32 * NP);
    __syncthreads();
    for (int jt = 0; jt < ntiles; ++jt) {
        LAS bf16_t* KS = (LAS bf16_t*)(lds + (jt & 1) * 17408);
        LAS bf16_t* VS = (LAS bf16_t*)(lds + 34816 + (jt & 1) * 18432);
        *(LAS u32x4*)(KS + lr * 136 + lc) = rk0; *(LAS u32x4*)(KS + (lr + 32) * 136 + lc) = rk1;
        *(LAS u32x4*)(VS + lr * 144 + lc) = rv0; *(LAS u32x4*)(VS + (lr + 32) * 144 + lc) = rv1;
        __syncthreads();
        if (jt + 1 < ntiles) { pk += (size_t)64 * NP; pvv += (size_t)64 * NP;
            rk0 = *(const u32x4*)pk; rk1 = *(const u32x4*)(pk + (size_t)32 * NP); rv0 = *(const u32x4*)pvv; rv1 = *(const u32x4*)(pvv + (size_t)32 * NP); }
        const bool need_mask = (jt * 64 + 63 > q0 + 16 * wid);
        union { bf16x8 v; unsigned w[4]; } pb[2][2];
#pragma unroll
        for (int n = 0; n < 2; ++n) {
            f32x4 s[4];
#pragma unroll
            for (int it = 0; it < 4; ++it) {
                s[it] = (f32x4){0.f, 0.f, 0.f, 0.f};
#pragma unroll
                for (int ks = 0; ks < 2; ++ks) s[it] = MFMA16(*(const LAS bf16x8*)(KS + (it * 16 + c16) * 136 + n * 64 + ks * 32 + g * 8), qf[n][ks], s[it]);
            }
            if (need_mask) {
#pragma unroll
                for (int it = 0; it < 4; ++it)
#pragma unroll
                    for (int r = 0; r < 4; ++r) { const int key = jt * 64 + 16 * it + 4 * g + r; if (key > qrow) s[it][r] = -1e30f; }
            }
            float mx = -1e30f;
#pragma unroll
            for (int it = 0; it < 4; ++it) mx = fmaxf(mx, fmaxf(fmaxf(s[it][0], s[it][1]), fmaxf(s[it][2], s[it][3])));
            mx = fmaxf(mx, __shfl_xor(mx, 16)); mx = fmaxf(mx, __shfl_xor(mx, 32));
            const float mnew = (mx > mrow[n] + 8.0f) ? mx : mrow[n];
            float ps = 0.f;
#pragma unroll
            for (int it = 0; it < 4; ++it)
#pragma unroll
                for (int r = 0; r < 4; ++r) { s[it][r] = __builtin_amdgcn_exp2f(s[it][r] - mnew); ps += s[it][r]; }
            ps += __shfl_xor(ps, 16); ps += __shfl_xor(ps, 32);
            if (__builtin_amdgcn_ballot_w64(mnew != mrow[n]) != 0ull) {
                const float alpha = __builtin_amdgcn_exp2f(mrow[n] - mnew);
                lrow[n] = lrow[n] * alpha;
#pragma unroll
                for (int e = 0; e < 8; ++e) O[n][e] = O[n][e] * alpha;
            }
            lrow[n] += ps; mrow[n] = mnew;
#pragma unroll
            for (int ks = 0; ks < 2; ++ks) {
                pb[n][ks].w[0] = pk2(s[2 * ks][0], s[2 * ks][1]); pb[n][ks].w[1] = pk2(s[2 * ks][2], s[2 * ks][3]);
                pb[n][ks].w[2] = pk2(s[2 * ks + 1][0], s[2 * ks + 1][1]); pb[n][ks].w[3] = pk2(s[2 * ks + 1][2], s[2 * ks + 1][3]);
            }
        }
#pragma unroll
        for (int ks = 0; ks < 2; ++ks) {
            const LAS bf16_t* vb = VS + (32 * ks + 4 * g + (c16 >> 2)) * 144 + 4 * (c16 & 3);
#pragma unroll
            for (int e = 0; e < 8; ++e) {
                const bf16x8 vf = trfrag2(vb + 16 * e, vb + 16 * 144 + 16 * e);
                O[0][e] = MFMA16(vf, pb[0][ks].v, O[0][e]); O[1][e] = MFMA16(vf, pb[1][ks].v, O[1][e]);
            }
        }
    }
    {
        const float i0 = 1.0f / lrow[0], i1 = lam / lrow[1]; float ss = 0.f;
#pragma unroll
        for (int e = 0; e < 8; ++e) { O[0][e] = O[0][e] * i0 - O[1][e] * i1; ss += (O[0][e][0] * O[0][e][0] + O[0][e][1] * O[0][e][1]) + (O[0][e][2] * O[0][e][2] + O[0][e][3] * O[0][e][3]); }
        ss += __shfl_xor(ss, 16); ss += __shfl_xor(ss, 32);
        const float rsn = 1.0f / sqrtf(ss * (1.0f / 128.0f) + NORM_EPS) * (1.0f - lam_init);
        bf16_t* orow = ha + ((size_t)b * SEQ + qrow) * 1024 + h * 128 + 4 * g;
        const float* nw = a_norm_w + l * 1024 + h * 128 + 4 * g;
#pragma unroll
        for (int e = 0; e < 8; ++e) {
            const f32x4 wv = *(const f32x4*)(nw + 16 * e);
            u32x2 w; w.x = pk2(O[0][e][0] * rsn * wv[0], O[0][e][1] * rsn * wv[1]); w.y = pk2(O[0][e][2] * rsn * wv[2], O[0][e][3] * rsn * wv[3]);
            *(u32x2*)(orow + 16 * e) = w;
        }
    }
}


#define XB_TMO      128
#define XB_XCNT(j)  (256  + 64 * (j))
#define XB_XSUB(j)  (1280 + 64 * (j))
#define XB_XGEN(j)  (2304 + 64 * (j))
#define XB_TOP      3328
#define XB_TOPGEN   3392
#define XCD_BAR_WORDS 3456
#define XB_SPIN_CAP (1u << 18)
__device__ __forceinline__ unsigned xb_ld(unsigned* p)              { return __hip_atomic_load(p, __ATOMIC_RELAXED, __HIP_MEMORY_SCOPE_AGENT); }
__device__ __forceinline__ unsigned xb_add(unsigned* p, unsigned v) { return __hip_atomic_fetch_add(p, v, __ATOMIC_RELAXED, __HIP_MEMORY_SCOPE_AGENT); }
__device__ __forceinline__ unsigned xb_xcc_id() { return (unsigned)__builtin_amdgcn_s_getreg((3 << 11) | 20) & 0xFu; }
#define XB_SPIN(cond, bar) do { unsigned _sp = 0; while (cond) { \
    if ((++_sp & 255u) == 0u) { if (xb_ld(&(bar)[XB_TMO])) break; if (_sp > XB_SPIN_CAP) { atomicAdd(&(bar)[XB_TMO], 1u); break; } } } } while (0)
struct XcdBarrier { unsigned* bar; unsigned x; volatile LAS unsigned* st; };
__device__ __forceinline__ XcdBarrier xcd_barrier_post(unsigned* bar, volatile LAS unsigned* st) {
    XcdBarrier b; b.bar = bar; b.x = xb_xcc_id(); b.st = st;
    if (threadIdx.x == 0) (void)xb_add(&bar[XB_XCNT(b.x)], 1u);
    return b;
}
__device__ __forceinline__ void xcd_barrier_complete(unsigned* bar, unsigned x, unsigned& nloc, unsigned& nx) {
    const unsigned G = gridDim.x * gridDim.y * gridDim.z;
    unsigned sum, cnt, mine, sp = 0u;
    for (;;) {
        sum = 0u; cnt = 0u; mine = 0u;
#pragma unroll
        for (unsigned j = 0; j < 16; ++j) { const unsigned c = xb_ld(&bar[XB_XCNT(j)]); sum += c; cnt += (c > 0u) ? 1u : 0u; mine = (j == x) ? c : mine; }
        if (sum == G) break;
        __builtin_amdgcn_s_sleep(1);
        if ((++sp & 255u) == 0u) { if (xb_ld(&bar[XB_TMO])) break; if (sp > XB_SPIN_CAP) { atomicAdd(&bar[XB_TMO], 1u); break; } }
    }
    nloc = mine > 0u ? mine : 1u; nx = cnt > 0u ? cnt : 1u;
}
__device__ __forceinline__ void xcd_barrier(const XcdBarrier& b) {
    asm volatile("s_waitcnt vmcnt(0)" ::: "memory");
    __syncthreads();
    if (threadIdx.x == 0) {
        unsigned* bar = b.bar;
        __builtin_amdgcn_s_waitcnt(0);
        unsigned nloc = b.st[0], nx = b.st[1];
        if (nloc == 0u) { xcd_barrier_complete(bar, b.x, nloc, nx); b.st[0] = nloc; b.st[1] = nx; }
        const unsigned old = xb_add(&bar[XB_XSUB(b.x)], 1u);
        const unsigned gen = old / nloc;
        if (old + 1u == (gen + 1u) * nloc) {
            __builtin_amdgcn_fence(__ATOMIC_RELEASE, "agent");
            asm volatile("s_waitcnt vmcnt(0)" ::: "memory");
            const unsigned og = xb_add(&bar[XB_TOP], 1u);
            const unsigned tg = og / nx;
            if (og + 1u == (tg + 1u) * nx) xb_add(&bar[XB_TOPGEN], 1u);
            else XB_SPIN(xb_ld(&bar[XB_TOPGEN]) == tg, bar);
            __builtin_amdgcn_fence(__ATOMIC_ACQUIRE, "agent");
            xb_add(&bar[XB_XGEN(b.x)], 1u);
            asm volatile("s_waitcnt vmcnt(0)" ::: "memory");
        } else {
            XB_SPIN(xb_ld(&bar[XB_XGEN(b.x)]) == gen, bar);
            __builtin_amdgcn_fence(__ATOMIC_ACQUIRE, "agent");
            asm volatile("s_waitcnt vmcnt(0)" ::: "memory");
        }
    }
    __syncthreads();
}

__global__ void __launch_bounds__(NTHREADS, 2) fwd_megakernel(Params P) {
    extern __shared__ __attribute__((aligned(16))) unsigned char lds_raw[];
    LAS unsigned char* lds = (LAS unsigned char*)lds_raw;
    cg::grid_group grid = cg::this_grid();
    volatile LAS unsigned* bst = (volatile LAS unsigned*)(lds + LDS_BYTES - 16);
    if (threadIdx.x == 0) { bst[0] = 0u; bst[1] = 0u; }
    __syncthreads();
    const XcdBarrier xbar = xcd_barrier_post((unsigned*)(KWS + WS_BAR), bst);
    const int G = gridDim.x, bid = blockIdx.x;
#define positions ((const int*)KIN(1))
#define w_in KIN(4)
#define conv_w KIN(5)
#define conv_b KIN(6)
#define gate_b KIN(7)
#define m_norm_w KIN(8)
#define a_lambda KIN(9)
#define a_norm_w KIN(10)
#define lb_logits KIN(11)
#define g_norm_w KIN(12)
#define B_Hf ((float*)(KWS + WS_H))
#define B_Hb ((bf16_t*)(KWS + WS_HB))
#define B_PROJ ((bf16_t*)(KWS + WS_PROJ))
#define B_ACT B_PROJ
#define B_HCAT ((bf16_t*)(KWS + WS_HCAT))
#define B_MPART ((bf16_t*)(KWS + WS_MPART))
#define B_DPART ((float*)(KWS + WS_DPART))
#define B_HPART ((bf16_t*)(KWS + WS_HPART))
#define B_YF ((float*)(KWS + WS_YF))
#define B_YB ((bf16_t*)(KWS + WS_YB))
#define B_TF ((float*)(KWS + WS_TF))
#define B_GIF ((float*)(KWS + WS_GPART))
#define B_ROPE ((float*)(KWS + WS_ROPE))
    {
        const int tid = launder_i(threadIdx.x), lane = tid & 63, wid = tid >> 6;
        LAS float* scr = (LAS float*)(lds + wid * 16640);
        const int gw = bid * NWAVES + wid, NGW = G * NWAVES;
        constexpr int I_IN = (D / 64) * (NP / 64), I_P = (1024 / 64) * (D / 64), I_O = (D / 64) * (D / 64), I_U = (D / 64) * (FF / 64), I_D = (FF / 64) * (D / 64);
        constexpr int I_L = I_IN + 3 * I_P + I_O + I_U + I_D;
        const float* q_win = KIN(4); const float* q_pm = KIN(13); const float* q_pa = KIN(14); const float* q_pg = KIN(15); const float* q_wo = KIN(16); const float* q_up = KIN(19); const float* q_dn = KIN(20);
        unsigned char* q_ws = KWS; const int* q_pos = (const int*)KIN(1);
        for (int rp0 = 0; rp0 < REP_P0; ++rp0)
        for (int it = gw; it < DEPTH * I_L; it += NGW) {
            const int l = it / I_L; int r = it % I_L;
            if (r < I_IN) { tr_matrix_item(q_win + (size_t)l * D * NSRC, D, NP, NSRC, true, (bf16_t*)(q_ws + WS_WIN + l * SZ_WIN), r, scr, lane); continue; } r -= I_IN;
            if (r < I_P) { tr_matrix_item(q_pm + (size_t)l * 1024 * D, 1024, D, D, false, (bf16_t*)(q_ws + WS_WPM + l * SZ_WP), r, scr, lane); continue; } r -= I_P;
            if (r < I_P) { tr_matrix_item(q_pa + (size_t)l * 1024 * D, 1024, D, D, false, (bf16_t*)(q_ws + WS_WPA + l * SZ_WP), r, scr, lane); continue; } r -= I_P;
            if (r < I_P) { tr_matrix_item(q_pg + (size_t)l * 1024 * D, 1024, D, D, false, (bf16_t*)(q_ws + WS_WPG + l * SZ_WP), r, scr, lane); continue; } r -= I_P;
            if (r < I_O) { tr_matrix_item(q_wo + (size_t)l * D * D, D, D, D, false, (bf16_t*)(q_ws + WS_WOUT + l * SZ_WOUT), r, scr, lane); continue; } r -= I_O;
            if (r < I_U) { tr_matrix_item(q_up + (size_t)l * D * FF, D, FF, FF, false, (bf16_t*)(q_ws + WS_WUP + l * SZ_WUP), r, scr, lane); continue; } r -= I_U;
            tr_matrix_item(q_dn + (size_t)l * FF * D, FF, D, D, false, (bf16_t*)(q_ws + WS_WDN + l * SZ_WDN), r, scr, lane);
        }
        for (int i = bid * NTHREADS + tid; i < T * 8; i += G * NTHREADS) {
            const int row = i >> 3, f = i & 7;
            const float inv = powf(500000.0f, -(float)(2 * f) / 16.0f);
            const float ang = (float)q_pos[row] * inv;
            float* q_rope = (float*)(q_ws + WS_ROPE); q_rope[row * 16 + f] = cosf(ang); q_rope[row * 16 + 8 + f] = sinf(ang);
        }
        __syncthreads();
        ln_phase<true, true, false, false>(KIN(0), KIN(2), KIN(3), nullptr, B_Hb, w_in, gate_b, B_GIF, lds, G);
    }
    xcd_barrier(xbar);
    if (G == 0x40000000) grid.sync();

#pragma unroll 1
    for (int l = 0; l < DEPTH; ++l) {
        {
            pg8::Sched S; S.init(T, 16384, D, 1, G, bid);
            S.strideA = S.strideB = 0; S.A0 = (const char*)B_Hb; S.B0 = (const char*)(KWS + WS_WIN + l * SZ_WIN);
            pg8::EpiProj E; E.O = B_PROJ; E.rope = B_ROPE; E.pn_off = 0;
#if !defined(SKIP_GEMM) && !defined(SKIP_G0)
            for (int rep = 0; rep < REP_GEMM; ++rep) pg8::gemm_phase(lds, S, E);
#endif
        }
        xcd_barrier(xbar);
        {
            const int gm = G / 4, gh = G / 4, ga = G - gm - gh;
            if (bid < gm) { for (int rep = 0; rep < REP_M; ++rep) for (int u = bid; u < 64; u += gm) {
#ifndef SKIP_MLSTM
 mlstm_unit(u, l, B_PROJ, B_GIF, conv_w, conv_b, B_MPART + (size_t)(u & 3) * T * 1024, B_DPART + (size_t)(u & 3) * T * 4, (l > 0 && G == 256) ? 8 : 1, lds);
#endif
 } }
            else if (bid < gm + gh) { for (int rep = 0; rep < REP_H; ++rep) for (int u = bid - gm; u < 64; u += gh) {
#ifndef SKIP_HGRN
 hgrn_unit(u, l, B_PROJ, lb_logits, B_HPART + (size_t)(u & 1) * T * 1024, lds);
#endif
 } }
            else { for (int rep = 0; rep < REP_A; ++rep) for (int u = bid - gm - gh; u < 512; u += ga) {
#ifndef SKIP_ATTN
 attn_unit(u, l, B_PROJ, a_lambda, a_norm_w, B_HCAT + (size_t)T * 1024, lds);
#endif
 }
                {
                    __syncthreads();
                    pg8::Sched S; S.init(T, 1024, D, 1, ga, bid - gm - gh);
                    S.strideA = S.strideB = 0; S.A0 = (const char*)B_Hb; S.B0 = (const char*)(KWS + WS_WIN + l * SZ_WIN + (size_t)16384 * D * 2);
                    pg8::EpiProj E; E.O = B_PROJ; E.rope = B_ROPE; E.pn_off = 64;
                    pg8::gemm_phase(lds, S, E);
                }
            }
        }
        xcd_barrier(xbar);
        { const int tid = launder_i(threadIdx.x), lane = tid & 63, wid = tid >> 6;
        const bf16_t* q_mp = B_MPART; const float* q_dp = B_DPART; const bf16_t* q_hp = B_HPART; const float* q_mnw = m_norm_w; const float* q_gnw = g_norm_w; const bf16_t* q_proj = B_PROJ; bf16_t* q_hcat = B_HCAT;
        const int step = G * NWAVES;
        for (int it0 = bid * NWAVES + wid; it0 < T * 4; it0 += 2 * step) {
            f32x4 v[2]; float den[2]; u32x2 mo[2]; bool ok[2];
#pragma unroll
            for (int q = 0; q < 2; ++q) {
                const int it = it0 + q * step; ok[q] = it < T * 4; const int itc = ok[q] ? it : it0;
                const int row = itc >> 2, h = itc & 3; const size_t o = (size_t)row * 1024 + h * 256 + 4 * lane;
                v[q] = (f32x4){0.f, 0.f, 0.f, 0.f}; den[q] = 0.f;
#pragma unroll
                for (int dq = 0; dq < 4; ++dq) { const u32x2 p = *(const u32x2*)(q_mp + (size_t)dq * T * 1024 + o);
                    v[q][0] += bflo(p.x); v[q][1] += bfhi(p.x); v[q][2] += bflo(p.y); v[q][3] += bfhi(p.y); den[q] += q_dp[(size_t)dq * T * 4 + (size_t)row * 4 + h]; }
                mo[q] = *(const u32x2*)(q_proj + (size_t)row * NP + C_MO + h * 256 + 4 * lane);
            }
#pragma unroll
            for (int q = 0; q < 2; ++q) {
                const int it = it0 + q * step; const int itc = ok[q] ? it : it0; const int row = itc >> 2, h = itc & 3;
                const f32x4 x = v[q] * (1.0f / fmaxf(fabsf(den[q]), 1.0f));
                const float ss = wave_sum((x[0] * x[0] + x[1] * x[1]) + (x[2] * x[2] + x[3] * x[3]));
                const float rsn = 1.0f / sqrtf(ss * (1.0f / 256.0f) + NORM_EPS);
                const f32x4 wn = *(const f32x4*)(q_mnw + l * 1024 + h * 256 + 4 * lane);
                u32x2 ow;
                ow.x = pk2(x[0] * rsn * wn[0] * sigmoidf_(bflo(mo[q].x)), x[1] * rsn * wn[1] * sigmoidf_(bfhi(mo[q].x)));
                ow.y = pk2(x[2] * rsn * wn[2] * sigmoidf_(bflo(mo[q].y)), x[3] * rsn * wn[3] * sigmoidf_(bfhi(mo[q].y)));
                if (ok[q]) *(u32x2*)(q_hcat + (size_t)row * 1024 + h * 256 + 4 * lane) = ow;
            }
        }
        for (int it0 = bid * NWAVES + wid; it0 < T * 4; it0 += 2 * step) {
            f32x4 v[2]; u32x2 gg[2]; bool ok[2];
#pragma unroll
            for (int q = 0; q < 2; ++q) {
                const int it = it0 + q * step; ok[q] = it < T * 4; const int itc = ok[q] ? it : it0;
                const int row = itc >> 2, hp = itc & 3; const size_t o = (size_t)row * 1024 + hp * 256 + 4 * lane;
                const u32x2 p0 = *(const u32x2*)(q_hp + o), p1 = *(const u32x2*)(q_hp + (size_t)T * 1024 + o);
                v[q][0] = bflo(p0.x) + bflo(p1.x); v[q][1] = bfhi(p0.x) + bfhi(p1.x); v[q][2] = bflo(p0.y) + bflo(p1.y); v[q][3] = bfhi(p0.y) + bfhi(p1.y);
                gg[q] = *(const u32x2*)(q_proj + (size_t)row * NP + C_GG + hp * 256 + 4 * lane);
            }
#pragma unroll
            for (int q = 0; q < 2; ++q) {
                const int it = it0 + q * step; const int itc = ok[q] ? it : it0; const int row = itc >> 2, hp = itc & 3; const size_t o = (size_t)row * 1024 + hp * 256 + 4 * lane;
                const f32x4 x = v[q];
                float ss = (x[0] * x[0] + x[1] * x[1]) + (x[2] * x[2] + x[3] * x[3]);
#pragma unroll
                for (int off = 1; off < 32; off <<= 1) ss += __shfl_xor(ss, off);
                const float rsn = 1.0f / sqrtf(ss * (1.0f / 128.0f) + NORM_EPS);
                const f32x4 wn = *(const f32x4*)(q_gnw + l * 1024 + hp * 256 + 4 * lane);
                u32x2 ow;
                ow.x = pk2(x[0] * rsn * wn[0] * siluf_(bflo(gg[q].x)), x[1] * rsn * wn[1] * siluf_(bfhi(gg[q].x)));
                ow.y = pk2(x[2] * rsn * wn[2] * siluf_(bflo(gg[q].y)), x[3] * rsn * wn[3] * siluf_(bfhi(gg[q].y)));
                if (ok[q]) *(u32x2*)(q_hcat + (size_t)2 * T * 1024 + o) = ow;
            }
        } }
        xcd_barrier(xbar);
        {
            pg8::Sched S; S.init(T, D, 1024, 3, G, bid);
            S.A0 = (const char*)B_HCAT; S.strideA = T * 1024 * 2;
            S.B0 = (const char*)(KWS + WS_WPM + l * SZ_WP); S.strideB = (int)(DEPTH * SZ_WP);
            pg8::EpiMerge E; E.proj = B_PROJ; E.YB = B_YB;
#if !defined(SKIP_GEMM) && !defined(SKIP_G1)
            for (int rep = 0; rep < REP_GEMM; ++rep) pg8::gemm_phase(lds, S, E);
#endif
        }
        xcd_barrier(xbar);
        {
            pg8::Sched S; S.init(T, D, D, 1, G, bid);
            S.strideA = S.strideB = 0; S.A0 = (const char*)B_YB; S.B0 = (const char*)(KWS + WS_WOUT + l * SZ_WOUT);
            if (G == 256) {
                pg8::EpiLn<false, false> E; E.H = B_Hb; E.w = KIN(17) + l * D; E.b = KIN(18) + l * D; E.outB = B_Hb; E.outF = nullptr; E.win_next = nullptr; E.gbias = nullptr; E.gpart = nullptr;
                E.st.xbuf = (unsigned long long*)(KWS + WS_XBUF) + (size_t)l * T * 8; E.st.cnt = (unsigned*)(KWS + WS_CNT) + l * 32 * 64; E.st.eps = LN_EPS;
                pg8::gemm_phase(lds, S, E);
            } else {
                pg8::EpiResid E; E.H = B_Hb; E.TF = (bf16_t*)B_TF;
                pg8::gemm_phase(lds, S, E);
            }
        }
        xcd_barrier(xbar);
        if (G != 256) {
            ln_phase<false, true, false, true>(B_TF, KIN(17) + l * D, KIN(18) + l * D, nullptr, B_Hb, nullptr, nullptr, nullptr, lds, G);
            xcd_barrier(xbar);
        }
        {
            pg8::Sched S; S.init(T, FF, D, 1, G, bid);
            S.strideA = S.strideB = 0; S.A0 = (const char*)B_Hb; S.B0 = (const char*)(KWS + WS_WUP + l * SZ_WUP);
            pg8::EpiRelu2 E; E.O = B_ACT;
#if !defined(SKIP_GEMM) && !defined(SKIP_G3)
            for (int rep = 0; rep < REP_GEMM; ++rep) pg8::gemm_phase(lds, S, E);
#endif
        }
        xcd_barrier(xbar);
        {
            pg8::Sched S; S.init(T, D, FF, 1, G, bid);
            S.strideA = S.strideB = 0; S.A0 = (const char*)B_ACT; S.B0 = (const char*)(KWS + WS_WDN + l * SZ_WDN);
            if (G == 256 && l + 1 == DEPTH) {
                pg8::EpiLn<true, false> E; E.H = B_Hb; E.w = KIN(21) + l * D; E.b = KIN(22) + l * D; E.outB = nullptr; E.outF = kparams()->out; E.win_next = nullptr; E.gbias = nullptr; E.gpart = nullptr;
                E.st.xbuf = (unsigned long long*)(KWS + WS_XBUF) + (size_t)DEPTH * T * 8; E.st.cnt = (unsigned*)(KWS + WS_CNT) + DEPTH * 32 * 64; E.st.eps = LN_EPS;
                pg8::gemm_phase(lds, S, E);
            } else if (G == 256) {
                pg8::EpiLn<false, true> E; E.H = B_Hb; E.w = KIN(21) + l * D; E.b = KIN(22) + l * D; E.outB = B_Hb; E.outF = nullptr;
                E.win_next = w_in + (size_t)(l + 1) * D * NSRC; E.gbias = gate_b + (l + 1) * 8; E.gpart = B_GIF;
                E.st.xbuf = (unsigned long long*)(KWS + WS_XBUF) + (size_t)(DEPTH + 1 + l) * T * 8; E.st.cnt = (unsigned*)(KWS + WS_CNT) + (DEPTH + 1 + l) * 32 * 64; E.st.eps = LN_EPS;
                pg8::gemm_phase(lds, S, E);
            } else {
                pg8::EpiResid E; E.H = B_Hb; E.TF = (bf16_t*)B_TF;
                pg8::gemm_phase(lds, S, E);
            }
        }
        if (G == 256 && l + 1 == DEPTH) break;
        xcd_barrier(xbar);
        if (G == 256) continue;
        if (l + 1 < DEPTH) {
            ln_phase<true, true, false, true>(B_TF, KIN(21) + l * D, KIN(22) + l * D, nullptr, B_Hb, w_in + (size_t)(l + 1) * D * NSRC, gate_b + (l + 1) * 8, B_GIF, lds, G);
            xcd_barrier(xbar);
        } else {
            ln_phase<false, false, true, true>(B_TF, KIN(21) + l * D, KIN(22) + l * D, kparams()->out, nullptr, nullptr, nullptr, nullptr, lds, G);
        }
    }
}

extern "C" void kernel_launch(void* const* d_in, const int* in_sizes, int n_in, void* d_out, int out_size, void* d_ws, size_t ws_size, hipStream_t stream) {
    static int grid_blocks = 0;
    if (grid_blocks == 0) {
        if (n_in != 23 || out_size != T * D || ws_size < WS_END) { fprintf(stderr, "kernel_launch: unexpected shapes (n_in %d out %d ws %zu need %zu)\n", n_in, out_size, ws_size, (size_t)WS_END); grid_blocks = -1; return; }
        int dev = 0, cus = 0, per_cu = 0;
        hipGetDevice(&dev);
        hipDeviceGetAttribute(&cus, hipDeviceAttributeMultiprocessorCount, dev);
        if (hipFuncSetAttribute((const void*)fwd_megakernel, hipFuncAttributeMaxDynamicSharedMemorySize, LDS_BYTES) != hipSuccess) { fprintf(stderr, "kernel_launch: hipFuncSetAttribute failed\n"); grid_blocks = -1; return; }
        hipOccupancyMaxActiveBlocksPerMultiprocessor(&per_cu, (const void*)fwd_megakernel, NTHREADS, LDS_BYTES);
        if (per_cu < 1) { fprintf(stderr, "kernel_launch: occupancy query says %d blocks per CU\n", per_cu); per_cu = 1; }
        (void)hipGetLastError();
        grid_blocks = cus * 1;
    }
    if (grid_blocks < 0) return;
    if (hipMemsetAsync((char*)d_ws + WS_BAR, 0, WS_ZERO_BYTES, stream) != hipSuccess) { fprintf(stderr, "kernel_launch: memset failed\n"); return; }
    Params p{};
    for (int i = 0; i < 23; ++i) p.in[i] = (const float*)d_in[i];
    p.out = (float*)d_out; p.wsp = (unsigned char*)d_ws;
    void* args[] = {&p};
    hipError_t e = hipLaunchCooperativeKernel((const void*)fwd_megakernel, dim3(grid_blocks), dim3(NTHREADS), args, LDS_BYTES, stream);
    if (e != hipSuccess) fprintf(stderr, "cooperative launch failed: %s (grid %d)\n", hipGetErrorString(e), grid_blocks);
}
```
